# Optimizing an MI355X kernel written in HIP

```python
import math
import jax, jax.numpy as jnp
from jax import lax
import numpy as np

D_MODEL = 1024
BATCH = 16
SEQ = 2048
DEPTH = 1

HEAD_DIM = 64
NSA_HEADS = 8
NSA_KV_HEADS = 2
NSA_GROUP = NSA_HEADS // NSA_KV_HEADS
SB_HEADS = 8
CMP_LEN = 32
CMP_STRIDE = 16
CMP_HIDDEN = 256
SEL_LEN = 64
SEL_TOPK = 4
WINDOW = 512
Q_BLOCK = 128
N_BUCKETS = 32
MAX_DISTANCE = 128
D_FF = 4 * D_MODEL
EPS = 1e-6
NEG = -1e30
FORCE_BONUS = 1e4

NSA_Q_W = NSA_HEADS * HEAD_DIM
NSA_KV_W = NSA_KV_HEADS * HEAD_DIM
SB_W = SB_HEADS * HEAD_DIM
SPLITS = (NSA_Q_W, 6 * NSA_KV_W, 3 * NSA_HEADS, 3 * SB_W, 2 * D_MODEL)
IN_COLS = sum(SPLITS)

kernel_name = 'hybrid_nsa_stickbreaking_block'


def rmsnorm(x, g):
    xf = x.astype(jnp.float32)
    y = xf * lax.rsqrt(jnp.mean(xf * xf, axis=-1, keepdims=True) + EPS)
    return y * g.astype(jnp.float32)


def t5_bucket(dist):
    n = jnp.maximum(dist, 0)
    max_exact = N_BUCKETS // 2
    nf = jnp.maximum(n, 1).astype(jnp.float32)
    large = max_exact + (jnp.log(nf / max_exact) / math.log(MAX_DISTANCE / max_exact)
                         * (N_BUCKETS - max_exact)).astype(jnp.int32)
    return jnp.where(n < max_exact, n, jnp.minimum(large, N_BUCKETS - 1))


def compress_blocks(kv, pe, w1, b1, w2):
    b, t, g, dh = kv.shape
    n_cmp = (t - CMP_LEN) // CMP_STRIDE + 1
    idx = np.arange(n_cmp)[:, None] * CMP_STRIDE + np.arange(CMP_LEN)[None, :]
    blocks = kv[:, idx] + pe[None, None, :, None, :]
    flat = blocks.transpose(0, 1, 3, 2, 4).reshape(b, n_cmp, g, CMP_LEN * dh)
    hid = jax.nn.gelu(flat @ w1 + b1)
    return hid @ w2


def nsa_attention(q, kv, gate_logits, rel_bias, cmp_k, cmp_v):
    b, t = q.shape[:2]
    g, hg, dh = NSA_KV_HEADS, NSA_GROUP, HEAD_DIM
    scale = dh ** -0.5
    qg = q.reshape(b, t, g, hg, dh)
    k_c, v_c, k_s, v_s, k_w, v_w = (kv[:, :, i] for i in range(6))
    tbl = rel_bias.reshape(N_BUCKETS, g, hg)
    pos = jnp.arange(t)

    kc = compress_blocks(k_c, *cmp_k)
    vc = compress_blocks(v_c, *cmp_v)
    n_cmp = kc.shape[1]
    c_start = np.arange(n_cmp) * CMP_STRIDE
    dist_c = pos[:, None] - jnp.asarray(c_start + CMP_LEN - 1)[None, :]
    valid_c = dist_c >= 0
    bias_c = jnp.moveaxis(tbl[t5_bucket(dist_c)], (2, 3), (0, 1))
    s_c = (jnp.einsum('btgjd,bcgd->bgjtc', qg, kc) * scale + bias_c).astype(jnp.float32)
    p_c = jax.nn.softmax(jnp.where(valid_c, s_c, NEG), axis=-1) * valid_c
    o_cmp = jnp.einsum('bgjtc,bcgd->btgjd', p_c, vc)

    n_sel = t // SEL_LEN
    s_start = np.arange(n_sel) * SEL_LEN
    overlap = ((c_start[:, None] < s_start[None, :] + SEL_LEN)
               & (c_start[:, None] + CMP_LEN > s_start[None, :])).astype(np.float32)
    imp = jnp.einsum('bgjtc,cn->bgtn', p_c, jnp.asarray(overlap))
    blk = jnp.arange(n_sel)[None, :]
    sel_ok = jnp.asarray(s_start)[None, :] <= pos[:, None]
    forced = (blk == (pos // SEL_LEN)[:, None]) | (blk == 0)
    score = jnp.where(forced, imp + FORCE_BONUS, jnp.where(sel_ok, imp, -FORCE_BONUS))
    _, sel_idx = lax.top_k(score, SEL_TOPK)

    ks_blk = k_s.reshape(b, n_sel, SEL_LEN, g, dh).transpose(0, 3, 1, 2, 4)
    vs_blk = v_s.reshape(b, n_sel, SEL_LEN, g, dh).transpose(0, 3, 1, 2, 4)
    gather = jax.vmap(jax.vmap(lambda arr, i: arr[i]))
    kw_pad = jnp.pad(k_w, ((0, 0), (WINDOW, 0), (0, 0), (0, 0)))
    vw_pad = jnp.pad(v_w, ((0, 0), (WINDOW, 0), (0, 0), (0, 0)))
    g_idx = jnp.arange(g)[None, :, None, None, None]
    offs = jnp.arange(SEL_LEN)

    def block(s0):
        tq = s0 + jnp.arange(Q_BLOCK)
        qb = lax.dynamic_slice_in_dim(qg, s0, Q_BLOCK, axis=1)
        ib = lax.dynamic_slice_in_dim(sel_idx, s0, Q_BLOCK, axis=2)
        kb = gather(ks_blk, ib)
        vb = gather(vs_blk, ib)
        kpos = ib[..., None] * SEL_LEN + offs
        dist_s = tq[:, None, None] - kpos
        valid_s = (dist_s >= 0)[:, :, None]
        bias_s = jnp.moveaxis(tbl[t5_bucket(dist_s), g_idx], -1, 2)
        s_s = (jnp.einsum('bqgjd,bgqkld->bgjqkl', qb, kb) * scale + bias_s).astype(jnp.float32)
        s_s = jnp.where(valid_s, s_s, NEG).reshape(b, g, hg, Q_BLOCK, SEL_TOPK * SEL_LEN)
        p_s = jax.nn.softmax(s_s, axis=-1)
        o_s = jnp.einsum('bgjqn,bgqnd->bqgjd', p_s,
                         vb.reshape(b, g, Q_BLOCK, SEL_TOPK * SEL_LEN, dh))
        kwb = lax.dynamic_slice_in_dim(kw_pad, s0, WINDOW + Q_BLOCK, axis=1)
        vwb = lax.dynamic_slice_in_dim(vw_pad, s0, WINDOW + Q_BLOCK, axis=1)
        kpos_w = s0 - WINDOW + jnp.arange(WINDOW + Q_BLOCK)
        dist_w = tq[:, None] - kpos_w[None, :]
        valid_w = (dist_w >= 0) & (dist_w < WINDOW) & (kpos_w >= 0)[None, :]
        bias_w = jnp.moveaxis(tbl[t5_bucket(dist_w)], (2, 3), (0, 1))
        s_w = (jnp.einsum('bqgjd,bkgd->bgjqk', qb, kwb) * scale + bias_w).astype(jnp.float32)
        p_w = jax.nn.softmax(jnp.where(valid_w, s_w, NEG), axis=-1)
        o_w = jnp.einsum('bgjqk,bkgd->bqgjd', p_w, vwb)
        return o_s, o_w

    o_sel, o_win = lax.map(block, jnp.arange(t // Q_BLOCK) * Q_BLOCK)
    o_sel = jnp.moveaxis(o_sel, 0, 1).reshape(b, t, g, hg, dh)
    o_win = jnp.moveaxis(o_win, 0, 1).reshape(b, t, g, hg, dh)
    gts = jax.nn.sigmoid(gate_logits).reshape(b, t, g, hg, 3)
    o = gts[..., 0:1] * o_cmp + gts[..., 1:2] * o_sel + gts[..., 2:3] * o_win
    return o.reshape(b, t, NSA_HEADS * dh)


def stick_breaking_attention(q, k, v):
    b, t, h, dh = q.shape
    scale = dh ** -0.5
    kpos = jnp.arange(t)

    def block(s0):
        qb = lax.dynamic_slice_in_dim(q, s0, Q_BLOCK, axis=1)
        z = jnp.einsum('bqhd,bkhd->bhqk', qb, k).astype(jnp.float32) * scale
        tq = s0 + jnp.arange(Q_BLOCK)
        causal = kpos[None, :] < tq[:, None]
        log_beta = jax.nn.log_sigmoid(z)
        log_keep = jnp.where(causal, log_beta - z, 0.0)
        later = lax.cumsum(log_keep, axis=3, reverse=True) - log_keep
        a = jnp.where(causal, jnp.exp(log_beta + later), 0.0)
        return jnp.einsum('bhqk,bkhd->bqhd', a, v)

    o = lax.map(block, jnp.arange(t // Q_BLOCK) * Q_BLOCK)
    return jnp.moveaxis(o, 0, 1).reshape(b, t, h * dh)


def setup_inputs(seed: int = 0) -> dict:
    key = jax.random.key(seed)
    ks = jax.random.split(key, 20)

    def nrm(k, shape, scale):
        return jax.random.normal(k, shape, jnp.float32) * scale

    flat_in = CMP_LEN * HEAD_DIM
    return {
        'x': nrm(ks[0], (BATCH, SEQ, D_MODEL), 1.0),
        'norm_attn': 1.0 + nrm(ks[1], (DEPTH, D_MODEL), 0.1),
        'w_in': nrm(ks[2], (DEPTH, D_MODEL, IN_COLS), D_MODEL ** -0.5),
        'rel_bias': nrm(ks[3], (N_BUCKETS, NSA_HEADS), 0.5),
        'cmp_k_pe': nrm(ks[4], (DEPTH, CMP_LEN, HEAD_DIM), 0.1),
        'cmp_k_w1': nrm(ks[5], (DEPTH, flat_in, CMP_HIDDEN), flat_in ** -0.5),
        'cmp_k_b1': nrm(ks[6], (DEPTH, CMP_HIDDEN), 0.02),
        'cmp_k_w2': nrm(ks[7], (DEPTH, CMP_HIDDEN, HEAD_DIM), CMP_HIDDEN ** -0.5),
        'cmp_v_pe': nrm(ks[8], (DEPTH, CMP_LEN, HEAD_DIM), 0.1),
        'cmp_v_w1': nrm(ks[9], (DEPTH, flat_in, CMP_HIDDEN), flat_in ** -0.5),
        'cmp_v_b1': nrm(ks[10], (DEPTH, CMP_HIDDEN), 0.02),
        'cmp_v_w2': nrm(ks[11], (DEPTH, CMP_HIDDEN, HEAD_DIM), CMP_HIDDEN ** -0.5),
        'w_up_nsa': nrm(ks[12], (DEPTH, NSA_Q_W, D_MODEL), NSA_Q_W ** -0.5),
        'w_up_sb': nrm(ks[13], (DEPTH, SB_W, D_MODEL), SB_W ** -0.5),
        'w_out': nrm(ks[14], (DEPTH, D_MODEL, D_MODEL), D_MODEL ** -0.5),
        'norm_mlp': 1.0 + nrm(ks[15], (DEPTH, D_MODEL), 0.1),
        'w_ff1': nrm(ks[16], (DEPTH, D_MODEL, D_FF), D_MODEL ** -0.5),
        'w_ff2': nrm(ks[17], (DEPTH, D_FF, D_MODEL), D_FF ** -0.5),
        'norm_final': 1.0 + nrm(ks[18], (D_MODEL,), 0.1),
    }


def reference(x, norm_attn, w_in, rel_bias, cmp_k_pe, cmp_k_w1, cmp_k_b1, cmp_k_w2,
              cmp_v_pe, cmp_v_w1, cmp_v_b1, cmp_v_w2, w_up_nsa, w_up_sb, w_out,
              norm_mlp, w_ff1, w_ff2, norm_final):
    b, t, _ = x.shape
    split_at = np.cumsum(SPLITS)[:-1].tolist()
    for layer in range(DEPTH):
        h = rmsnorm(x, norm_attn[layer])
        proj = h @ w_in[layer]
        q_n, kv_n, g_n, qkv_s, g_m = jnp.split(proj, split_at, axis=-1)
        o_nsa = nsa_attention(
            q_n.reshape(b, t, NSA_HEADS, HEAD_DIM),
            kv_n.reshape(b, t, 6, NSA_KV_HEADS, HEAD_DIM),
            g_n.reshape(b, t, NSA_HEADS, 3),
            rel_bias,
            (cmp_k_pe[layer], cmp_k_w1[layer], cmp_k_b1[layer], cmp_k_w2[layer]),
            (cmp_v_pe[layer], cmp_v_w1[layer], cmp_v_b1[layer], cmp_v_w2[layer]))
        qkv = qkv_s.reshape(b, t, 3, SB_HEADS, HEAD_DIM)
        o_sb = stick_breaking_attention(qkv[:, :, 0], qkv[:, :, 1], qkv[:, :, 2])
        merge = jax.nn.sigmoid(g_m.reshape(b, t, 2, D_MODEL))
        mixed = merge[:, :, 0] * (o_nsa @ w_up_nsa[layer]) + merge[:, :, 1] * (o_sb @ w_up_sb[layer])
        x = x + mixed @ w_out[layer]
        h = rmsnorm(x, norm_mlp[layer])
        x = x + jnp.square(jax.nn.relu(h @ w_ff1[layer])) @ w_ff2[layer]
    return rmsnorm(x, norm_final)
```

```cpp
#define MK_N_LAUNCHES 1
#include <hip/hip_runtime.h>
#include <cstdio>
#include <cstdint>
namespace pg8 {
#define PG8_LAS __attribute__((address_space(3)))
typedef unsigned short bf16_t;
typedef short bf16x8 __attribute__((ext_vector_type(8)));
typedef float f32x4 __attribute__((ext_vector_type(4)));
typedef unsigned u32x4 __attribute__((ext_vector_type(4)));
constexpr int BM = 256, BK = 64, HALF = 128, HTB = HALF * BK * 2  , STAGE_BYTES = 8 * HTB, NXCD = 8, WGM = 8;

__host__ __device__ __forceinline__ int lds_byte(int r, int c) { const int st = (r >> 4) * 2 + (c >> 5), rr = r & 15, cc = c & 31, ob = rr * 64 + cc * 2; return st * 1024 + (ob ^ (((ob >> 9) & 1) << 5)); }
__host__ __device__ __forceinline__ void stage_rc(int b, int& R, int& C) { const int st = b / 1024, sb = b % 1024, swz = sb ^ (((sb >> 9) & 1) << 5); R = (st >> 1) * 16 + swz / 64; C = (st & 1) * 32 + (swz % 64) / 2; }
__host__ __device__ __forceinline__ int perm32(int rho) { const int n = rho >> 4, i = rho & 15; return 8 * (i >> 2) + 4 * n + (i & 3); }

struct Unit { int pm, pn; };
struct Gemm { const bf16_t* A; const bf16_t* Bt; int M, N, K; };

struct StaticOrder {
    int nM, nN, nwg, G, c;
    __host__ __device__ void init(int M, int N, int G_, int c_) { nM = M / BM; nN = N / BM; nwg = nM * nN; G = G_; c = c_; }
    __host__ __device__ bool next(int i, Unit& u) const {
        const long L = (long)i * G + c; if (L >= nwg) return false;
        int wgid = (int)L; { const int q = nwg / NXCD, r = nwg % NXCD, xcd = wgid % NXCD, off = wgid / NXCD; wgid = (xcd < r ? xcd * (q + 1) : r * (q + 1) + (xcd - r) * q) + off; }
        const int nig = WGM * nN, gid = wgid / nig, fm = gid * WGM, gsz = (nM - fm) < WGM ? (nM - fm) : WGM;
        u.pm = fm + ((wgid % nig) % gsz); u.pn = (wgid % nig) / gsz; return true;
    }
    __device__ __forceinline__ void a_ready(const Unit&) const {}
    __device__ __forceinline__ void done(const Unit&) const {}
};

__device__ __forceinline__ unsigned cvt_pk_bf16(float lo, float hi) { unsigned r; asm volatile("v_cvt_pk_bf16_f32 %0, %1, %2" : "=v"(r) : "v"(lo), "v"(hi)); return r; }
typedef float f32x2 __attribute__((ext_vector_type(2)));
template <class Epi, class Sched, bool ALIGN_EPI = false, bool SP2 = false>
__device__ __forceinline__ void gemm_phase(PG8_LAS unsigned char* lds, const Gemm g, const Sched& S, const Epi& E) {
    const int tid = threadIdx.x, wid = __builtin_amdgcn_readfirstlane(tid >> 6), lane = tid & 63, wr = wid >> 2, wc = wid & 3, fr = lane & 15, fq = lane >> 4;
    const int K = g.K, nt = K / BK;
    unsigned voffA[2], voffB[2];
#pragma unroll
    for (int i = 0; i < 2; ++i) { int R, C; stage_rc(tid * 16 + i * 8192, R, C); const int Rb = Epi::PERM ? ((R & ~31) + perm32(R & 31)) : R;
        voffA[i] = (unsigned)(R * K + C) * 2u; voffB[i] = (unsigned)(Rb * K + C) * 2u; }
    const size_t kstep = (size_t)(BK * 2);
    const size_t hstep = (size_t)HALF * K * 2;
    const size_t tstep = 2 * hstep;
    const unsigned ldsw = (unsigned)wid * 1024u;
    const int aoff = lds_byte(wr * 64 + fr, fq * 8), boff = lds_byte(wc * 32 + fr, fq * 8);
#define PG8_SA(b, h) (((b) * 2 + (h)) * HTB)
#define PG8_SB(b, h) ((4 + (b) * 2 + (h)) * HTB)
#define PG8_STAGE(bufoff, gbase, voff) do { _Pragma("unroll") for (int _i = 0; _i < 2; ++_i) \
        __builtin_amdgcn_global_load_lds((const unsigned*)((const char*)(gbase) + (voff)[_i]), (PG8_LAS unsigned*)(lds + (bufoff) + ldsw + _i * 8192), 16, 0, 0); } while (0)
#define PG8_LDA(dst, b, h) do { _Pragma("unroll") for (int m = 0; m < 4; ++m) _Pragma("unroll") for (int k = 0; k < 2; ++k) dst[m][k] = *(const PG8_LAS bf16x8*)(lds + PG8_SA(b, h) + aoff + m * 2048 + k * 1024); } while (0)
#define PG8_LDB(dst, b, h) do { _Pragma("unroll") for (int n = 0; n < 2; ++n) _Pragma("unroll") for (int k = 0; k < 2; ++k) dst[n][k] = *(const PG8_LAS bf16x8*)(lds + PG8_SB(b, h) + boff + n * 2048 + k * 1024); } while (0)
#define PG8_MMA(ai, bj, At, Bt) do { __builtin_amdgcn_s_setprio(1); _Pragma("unroll") for (int m = 0; m < 4; ++m) _Pragma("unroll") for (int n = 0; n < 2; ++n) _Pragma("unroll") for (int k = 0; k < 2; ++k) \
        acc[ai][bj][m][n] = __builtin_amdgcn_mfma_f32_16x16x32_bf16(Bt[n][k], At[m][k], acc[ai][bj][m][n], 0, 0, 0); __builtin_amdgcn_s_setprio(0); } while (0)
#define PG8_WAIT_V(n) asm volatile("s_waitcnt vmcnt(" #n ")" ::: "memory")
#define PG8_WAIT_L(n) asm volatile("s_waitcnt lgkmcnt(" #n ")" ::: "memory")
#define PG8_BAR __builtin_amdgcn_s_barrier()
#define PG8_SCHED __builtin_amdgcn_sched_barrier(0)
    Unit cur, nxt; int ui = 0;
    if (!S.next(0, cur)) return;
    f32x4 acc[2][2][4][2];
#pragma unroll
    for (int a = 0; a < 2; ++a)
#pragma unroll
        for (int b = 0; b < 2; ++b)
#pragma unroll
            for (int m = 0; m < 4; ++m)
#pragma unroll
                for (int n = 0; n < 2; ++n) acc[a][b][m][n] = (f32x4){0.f, 0.f, 0.f, 0.f};
    bf16x8 At[4][2], B0[2][2], B1[2][2];
    const char* cA = (const char*)g.A + (size_t)cur.pm * tstep; const char* cB = (const char*)g.Bt + (size_t)cur.pn * tstep;
    S.a_ready(cur);
    if constexpr (SP2) {
        PG8_STAGE(PG8_SB(0, 0), cB, voffB); PG8_STAGE(PG8_SB(0, 1), cB + hstep, voffB); PG8_STAGE(PG8_SA(0, 0), cA, voffA); PG8_STAGE(PG8_SA(0, 1), cA + hstep, voffA);
        if (wr == 1) PG8_BAR;
        PG8_WAIT_V(2); PG8_BAR;
        PG8_STAGE(PG8_SB(1, 0), cB + kstep, voffB); PG8_STAGE(PG8_SA(1, 0), cA + kstep, voffA); PG8_STAGE(PG8_SB(1, 1), cB + hstep + kstep, voffB);
        PG8_WAIT_V(6); PG8_BAR;
    } else {
        PG8_STAGE(PG8_SB(0, 0), cB, voffB); PG8_STAGE(PG8_SA(0, 0), cA, voffA); PG8_STAGE(PG8_SB(0, 1), cB + hstep, voffB); PG8_STAGE(PG8_SA(0, 1), cA + hstep, voffA);
        if (wr == 1) PG8_BAR;
        PG8_WAIT_V(4); PG8_BAR;
        PG8_STAGE(PG8_SB(1, 0), cB + kstep, voffB); PG8_STAGE(PG8_SA(1, 0), cA + kstep, voffA); PG8_STAGE(PG8_SB(1, 1), cB + hstep + kstep, voffB);
        PG8_WAIT_V(6); PG8_BAR;
    }
    for (;;) {
        const bool has_next = S.next(ui + 1, nxt);
        const char* nA = has_next ? (const char*)g.A + (size_t)nxt.pm * tstep : cA; const char* nB = has_next ? (const char*)g.Bt + (size_t)nxt.pn * tstep : cB;
        for (int t = 0; t < nt; t += 2) {
            const bool last = (t == nt - 2);
            const char* a1 = cA + (size_t)(t + 1) * kstep;
            const char* a2 = last ? nA : cA + (size_t)(t + 2) * kstep; const char* b2 = last ? nB : cB + (size_t)(t + 2) * kstep;
            const char* a3 = a2 + kstep; const char* b3 = b2 + kstep;
            if (last && has_next) S.a_ready(nxt);
            if constexpr (SP2) {
            PG8_LDB(B0, 0, 0); PG8_LDB(B1, 0, 1); PG8_SCHED; PG8_LDA(At, 0, 0); PG8_STAGE(PG8_SA(1, 1), a1 + hstep, voffA);
            PG8_WAIT_V(8); PG8_WAIT_L(0); PG8_BAR; PG8_MMA(0, 0, At, B0); PG8_MMA(0, 1, At, B1); PG8_BAR; PG8_SCHED;
            PG8_LDA(At, 0, 1); PG8_STAGE(PG8_SB(0, 0), b2, voffB); PG8_STAGE(PG8_SB(0, 1), b2 + hstep, voffB); PG8_STAGE(PG8_SA(0, 0), a2, voffA);
            PG8_WAIT_V(8); PG8_WAIT_L(0); PG8_BAR; PG8_MMA(1, 0, At, B0); PG8_MMA(1, 1, At, B1); PG8_BAR; PG8_SCHED;
            PG8_LDB(B0, 1, 0); PG8_LDB(B1, 1, 1); PG8_SCHED; PG8_LDA(At, 1, 0); PG8_STAGE(PG8_SA(0, 1), a2 + hstep, voffA);
            PG8_WAIT_V(8); PG8_WAIT_L(0); PG8_BAR; PG8_MMA(0, 0, At, B0); PG8_MMA(0, 1, At, B1); PG8_BAR; PG8_SCHED;
            PG8_LDA(At, 1, 1); PG8_STAGE(PG8_SB(1, 0), b3, voffB); PG8_STAGE(PG8_SB(1, 1), b3 + hstep, voffB); PG8_STAGE(PG8_SA(1, 0), a3, voffA);
            PG8_WAIT_V(8); PG8_WAIT_L(0); PG8_BAR; PG8_MMA(1, 0, At, B0); PG8_MMA(1, 1, At, B1); PG8_BAR; PG8_SCHED;
            } else {
            PG8_LDB(B0, 0, 0); PG8_SCHED; PG8_LDA(At, 0, 0); PG8_STAGE(PG8_SA(1, 1), a1 + hstep, voffA);
            PG8_WAIT_L(8); PG8_BAR; PG8_WAIT_L(0); PG8_MMA(0, 0, At, B0); PG8_BAR; PG8_SCHED;
            PG8_LDB(B1, 0, 1); PG8_STAGE(PG8_SB(0, 0), b2, voffB);
            PG8_BAR; PG8_WAIT_L(0); PG8_MMA(0, 1, At, B1); PG8_BAR;
            PG8_LDA(At, 0, 1); PG8_STAGE(PG8_SA(0, 0), a2, voffA);
            PG8_BAR; PG8_WAIT_L(0); PG8_MMA(1, 0, At, B0); PG8_BAR; PG8_SCHED;
            PG8_STAGE(PG8_SB(0, 1), b2 + hstep, voffB);
            PG8_WAIT_V(6); PG8_BAR; PG8_MMA(1, 1, At, B1); PG8_BAR;
            PG8_LDB(B0, 1, 0); PG8_SCHED; PG8_LDA(At, 1, 0); PG8_STAGE(PG8_SA(0, 1), a2 + hstep, voffA);
            PG8_WAIT_L(8); PG8_BAR; PG8_WAIT_L(0); PG8_MMA(0, 0, At, B0); PG8_BAR; PG8_SCHED;
            PG8_LDB(B1, 1, 1); PG8_STAGE(PG8_SB(1, 0), b3, voffB);
            PG8_BAR; PG8_WAIT_L(0); PG8_MMA(0, 1, At, B1); PG8_BAR;
            PG8_LDA(At, 1, 1); PG8_STAGE(PG8_SA(1, 0), a3, voffA);
            PG8_BAR; PG8_WAIT_L(0); PG8_MMA(1, 0, At, B0); PG8_BAR; PG8_SCHED;
            PG8_STAGE(PG8_SB(1, 1), b3 + hstep, voffB);
            PG8_WAIT_V(6); PG8_BAR; PG8_MMA(1, 1, At, B1); PG8_BAR;
            }
        }
        if constexpr (ALIGN_EPI) { if (wr == 0) PG8_BAR; }
        if constexpr (!Epi::AFTER_DRAIN) { E(acc, cur, wr, wc, fr, fq); S.done(cur); }
        if (!has_next) break;
#pragma unroll
        for (int a = 0; a < 2; ++a)
#pragma unroll
            for (int b = 0; b < 2; ++b)
#pragma unroll
                for (int m = 0; m < 4; ++m)
#pragma unroll
                    for (int n = 0; n < 2; ++n) acc[a][b][m][n] = (f32x4){0.f, 0.f, 0.f, 0.f};
        cur = nxt; cA = nA; cB = nB; ++ui;
        if constexpr (ALIGN_EPI) { if (wr == 1) PG8_BAR; }
    }
    PG8_WAIT_V(0);
    if constexpr (!ALIGN_EPI) { if (wr == 0) PG8_BAR; }
    PG8_BAR;
    if constexpr (Epi::AFTER_DRAIN) { E.fused(acc, cur, wr, wc, fr, fq, lds, wid, lane); S.done(cur); }
#undef PG8_SA
#undef PG8_SB
#undef PG8_STAGE
#undef PG8_LDA
#undef PG8_LDB
#undef PG8_MMA
#undef PG8_WAIT_V
#undef PG8_WAIT_L
#undef PG8_BAR
#undef PG8_SCHED
}
}
#define GAS __attribute__((address_space(1)))
#define LAS __attribute__((address_space(3)))
typedef unsigned short bf16;
typedef unsigned v4u __attribute__((ext_vector_type(4)));
typedef float f32x4 __attribute__((ext_vector_type(4)));
typedef short bf16x8 __attribute__((ext_vector_type(8)));
typedef GAS unsigned gu32;
typedef GAS unsigned long long gu64;
#define RLX_AGENT __ATOMIC_RELAXED, __HIP_MEMORY_SCOPE_AGENT
#define LDS_WAIT() asm volatile("s_waitcnt lgkmcnt(0)" ::: "memory")
#define VM_WAIT() asm volatile("s_waitcnt vmcnt(0)" ::: "memory")
__device__ __forceinline__ unsigned long long rt() { return __builtin_amdgcn_s_memrealtime(); }
__device__ __forceinline__ unsigned f2bf(float f) { unsigned u = __builtin_bit_cast(unsigned, f); return (u + 0x7fffu + ((u >> 16) & 1u)) >> 16; }
__device__ __forceinline__ unsigned pk2(float lo, float hi) { return f2bf(lo) | (f2bf(hi) << 16); }

#define XB_TMO      128
#define XB_XCNT(j)  (256  + 64 * (j))
#define XB_XSUB(j)  (1280 + 64 * (j))
#define XB_XGEN(j)  (2304 + 64 * (j))
#define XB_TOP      3328
#define XB_TOPGEN   3392
#define XCD_BAR_WORDS 3456
#define XB_SPIN_CAP (1u << 18)

__device__ __forceinline__ unsigned xb_ld(unsigned* p)              { return __hip_atomic_load(p, __ATOMIC_RELAXED, __HIP_MEMORY_SCOPE_AGENT); }
__device__ __forceinline__ unsigned xb_add(unsigned* p, unsigned v) { return __hip_atomic_fetch_add(p, v, __ATOMIC_RELAXED, __HIP_MEMORY_SCOPE_AGENT); }
__device__ __forceinline__ unsigned xb_xcc_id() { return (unsigned)__builtin_amdgcn_s_getreg((3 << 11) | 20) & 0xFu; }
#define XB_SPIN(cond, bar) do { unsigned _sp = 0; while (cond) { __builtin_amdgcn_s_sleep(1); \
    if ((++_sp & 255u) == 0u) { if (xb_ld(&(bar)[XB_TMO])) break; if (_sp > XB_SPIN_CAP) { atomicAdd(&(bar)[XB_TMO], 1u); break; } } } } while (0)

struct XcdBarrier {
    unsigned* bar; unsigned x;
    volatile LAS unsigned* st;
};

__device__ __forceinline__ XcdBarrier xcd_barrier_post(unsigned* bar, volatile LAS unsigned* st) {
    XcdBarrier b; b.bar = bar; b.x = xb_xcc_id(); b.st = st;
    if (threadIdx.x == 0) (void)xb_add(&bar[XB_XCNT(b.x)], 1u);
    return b;
}
__device__ __forceinline__ void xcd_barrier_complete(unsigned* bar, unsigned x, unsigned& nloc, unsigned& nx) {
    const unsigned G = gridDim.x * gridDim.y * gridDim.z;
    unsigned sum, cnt, mine, sp = 0u;
    for (;;) {
        sum = 0u; cnt = 0u; mine = 0u;
#pragma unroll
        for (unsigned j = 0; j < 16; ++j) { const unsigned c = xb_ld(&bar[XB_XCNT(j)]); sum += c; cnt += (c > 0u) ? 1u : 0u; mine = (j == x) ? c : mine; }
        if (sum == G) break;
        __builtin_amdgcn_s_sleep(1);
        if ((++sp & 255u) == 0u) { if (xb_ld(&bar[XB_TMO])) break; if (sp > XB_SPIN_CAP) { atomicAdd(&bar[XB_TMO], 1u); break; } }
    }
    nloc = mine > 0u ? mine : 1u; nx = cnt > 0u ? cnt : 1u;
}

__device__ __forceinline__ void xcd_barrier(const XcdBarrier& b) {
    asm volatile("s_waitcnt vmcnt(0)" ::: "memory");
    __syncthreads();
    if (threadIdx.x == 0) {
        unsigned* bar = b.bar;
        __builtin_amdgcn_s_waitcnt(0);
        unsigned nloc = b.st[0], nx = b.st[1];
        if (nloc == 0u) { xcd_barrier_complete(bar, b.x, nloc, nx); b.st[0] = nloc; b.st[1] = nx; }
        const unsigned old = xb_add(&bar[XB_XSUB(b.x)], 1u);
        const unsigned gen = old / nloc;
        if (old + 1u == (gen + 1u) * nloc) {
            __builtin_amdgcn_fence(__ATOMIC_RELEASE, "agent");
            asm volatile("s_waitcnt vmcnt(0)" ::: "memory");
            const unsigned og = xb_add(&bar[XB_TOP], 1u);
            const unsigned tg = og / nx;
            if (og + 1u == (tg + 1u) * nx) xb_add(&bar[XB_TOPGEN], 1u);
            else XB_SPIN(xb_ld(&bar[XB_TOPGEN]) == tg, bar);
            __builtin_amdgcn_fence(__ATOMIC_ACQUIRE, "agent");
            xb_add(&bar[XB_XGEN(b.x)], 1u);
            asm volatile("s_waitcnt vmcnt(0)" ::: "memory");
        } else {
            XB_SPIN(xb_ld(&bar[XB_XGEN(b.x)]) == gen, bar);
            __builtin_amdgcn_fence(__ATOMIC_ACQUIRE, "agent");
            asm volatile("s_waitcnt vmcnt(0)" ::: "memory");
        }
    }
    __syncthreads();
}

typedef float f32x16 __attribute__((ext_vector_type(16)));
typedef short s16x4 __attribute__((ext_vector_type(4)));
typedef unsigned v2u __attribute__((ext_vector_type(2)));

constexpr int NWAVES = 8;
constexpr int BATCH = 16, SEQ = 2048, DM = 1024, M = BATCH * SEQ;
constexpr int FF = 4096;
constexpr int IN_COLS = 4888, N1 = 5120;
constexpr float EPS = 1e-6f;
constexpr float LOG2E = 1.4426950408889634f;
constexpr float QSCALE = 0.125f * LOG2E;
constexpr float NEGBIG = -1e30f;

__constant__ unsigned char T5B[129] = {0,1,2,3,4,5,6,7,8,9,10,11,12,13,14,15,16,16,16,17,17,18,18,18,19,19,19,20,20,20,20,21,21,21,21,22,22,22,22,22,23,23,23,23,23,23,24,24,24,24,24,24,25,25,25,25,25,25,25,26,26,26,26,26,26,26,26,27,27,27,27,27,27,27,27,27,27,28,28,28,28,28,28,28,28,28,28,29,29,29,29,29,29,29,29,29,29,29,29,30,30,30,30,30,30,30,30,30,30,30,30,30,30,31,31,31,31,31,31,31,31,31,31,31,31,31,31,31,31};

constexpr size_t MiB = 1u << 20;
constexpr size_t WS_CTL = 0, CTL_ZERO_BYTES = 1 * MiB;
constexpr size_t WS_ROWSS = 512 * 1024;
constexpr size_t WS_WIN = 2 * MiB, WS_WN = 12 * MiB, WS_WSB = 13 * MiB, WS_WO = 14 * MiB, WS_W1 = 16 * MiB, WS_W2 = 24 * MiB;
constexpr size_t WS_CW1K = 32 * MiB, WS_CW1V = 33 * MiB, WS_CW2K = 34 * MiB, WS_CW2V = 34 * MiB + 65536;
constexpr size_t WS_KC = 35 * MiB, WS_VC = 36 * MiB;
constexpr size_t WS_XN = 40 * MiB;
constexpr size_t WS_QN = 104 * MiB;
constexpr size_t WS_KV = 136 * MiB;
constexpr size_t WS_SB = 184 * MiB;
constexpr size_t WS_GN = 280 * MiB;
constexpr size_t WS_GM = 284 * MiB;
constexpr size_t WS_END = 412 * MiB;
constexpr size_t WS_ONSA = 40 * MiB, WS_OSB = 72 * MiB;
constexpr size_t WS_MIX = 184 * MiB;
constexpr size_t WS_F = 40 * MiB;
constexpr size_t WS_X1B = 348 * MiB;
constexpr size_t KVARR = (size_t)BATCH * 2 * SEQ * 64;
constexpr size_t SBARR = (size_t)BATCH * 8 * SEQ * 64;
constexpr int CW_BAR = 4096;

constexpr int RING_OFF = 0, RING_BYTES = 131072;
constexpr int LDSCTL_OFF = RING_BYTES, MISC_OFF = LDSCTL_OFF + 320;
constexpr int LDS_BYTES = 147456;

#ifndef MK_N_LAUNCHES
#define MK_N_LAUNCHES 1
#endif
constexpr int N_PHASES = 10;

struct Frame {
    LAS unsigned char* lds;
    volatile LAS unsigned* MISC;
    gu32* ctl;
    int tid, lane, wave;
    int vcu, G;
};

__device__ __forceinline__ float wave_sum(float v) {
#pragma unroll
    for (int o = 1; o < 64; o <<= 1) v += __shfl_xor(v, o);
    return v;
}
__device__ __forceinline__ float bf2f(unsigned short b) { return __builtin_bit_cast(float, (unsigned)b << 16); }
__device__ __forceinline__ float fast_exp2(float x) { return __builtin_amdgcn_exp2f(x); }
__device__ __forceinline__ float fast_sigmoid(float x) { return __builtin_amdgcn_rcpf(1.0f + fast_exp2(-x * LOG2E)); }
typedef float f32x2_t __attribute__((ext_vector_type(2))); typedef __bf16 bf16x2_t __attribute__((ext_vector_type(2)));
__device__ __forceinline__ unsigned cvtpk(float lo, float hi) { f32x2_t v = {lo, hi}; bf16x2_t b = __builtin_convertvector(v, bf16x2_t); return __builtin_bit_cast(unsigned, b); }

__device__ __forceinline__ void transpose_item(const float* W, int K, int ldn, int n0, const float* kscale, bf16* WT, int drow0, LAS float* scr, int kb, int lane) {
    const int k0 = 64 * kb;
    const int c = lane & 7;
    if (n0 < 0) {
#pragma unroll
        for (int j = 0; j < 4; ++j) { const int n = (lane >> 3) + 8 * j; *(GAS v4u*)(WT + (size_t)(drow0 + n) * K + k0 + 8 * c) = (v4u){0u, 0u, 0u, 0u}; }
        return;
    }
#pragma unroll 8
    for (int i = 0; i < 32; ++i) { const int kk = 2 * i + (lane >> 5); float v = W[(size_t)(k0 + kk) * ldn + n0 + (lane & 31)]; if (kscale) v *= kscale[k0 + kk]; scr[kk * 33 + (lane & 31)] = v; }
    LDS_WAIT(); asm volatile("" ::: "memory");
#pragma unroll
    for (int j = 0; j < 4; ++j) { const int n = (lane >> 3) + 8 * j; const LAS float* s = scr + (8 * c) * 33 + n;
        v4u o; o.x = pk2(s[0 * 33], s[1 * 33]); o.y = pk2(s[2 * 33], s[3 * 33]); o.z = pk2(s[4 * 33], s[5 * 33]); o.w = pk2(s[6 * 33], s[7 * 33]);
        *(GAS v4u*)(WT + (size_t)(drow0 + n) * K + k0 + 8 * c) = o; }
    LDS_WAIT(); asm volatile("" ::: "memory");
}
__device__ __forceinline__ void rms_row_to_bf16(int lane, const float* xrow, const float* g, bf16* orow) {
    const GAS f32x4* xr = (const GAS f32x4*)xrow + lane; const GAS f32x4* gr = (const GAS f32x4*)g + lane;
    f32x4 v[4]; float s = 0.f;
#pragma unroll
    for (int j = 0; j < 4; ++j) { v[j] = xr[64 * j]; s += (v[j].x * v[j].x + v[j].y * v[j].y) + (v[j].z * v[j].z + v[j].w * v[j].w); }
    const float rstd = 1.f / sqrtf(wave_sum(s) * (1.f / DM) + EPS);
    GAS unsigned long long* o8 = (GAS unsigned long long*)orow + lane;
#pragma unroll
    for (int j = 0; j < 4; ++j) { const f32x4 gg = gr[64 * j];
        o8[64 * j] = (unsigned long long)pk2(v[j].x * rstd * gg.x, v[j].y * rstd * gg.y) | ((unsigned long long)pk2(v[j].z * rstd * gg.z, v[j].w * rstd * gg.w) << 32); }
}
struct In { const float* p[19]; };
__device__ __forceinline__ void p0_prologue(Frame& F, const In& in, unsigned char* ws) {
    LAS float* scr = (LAS float*)(F.lds + RING_OFF + F.wave * 16384);
    const int gw = F.vcu * NWAVES + F.wave, NGW = F.G * NWAVES;
    constexpr int I_IN = 16 * 160, I_UP = 8 * 32, I_O = 16 * 32, I_1 = 16 * 128, I_2 = 64 * 32, I_C1 = 32 * 8, I_C2 = 4 * 2;
    constexpr int NITEMS = I_IN + 2 * I_UP + I_O + I_1 + I_2 + 2 * I_C1 + 2 * I_C2;
    for (int it = gw; it < NITEMS; it += NGW) {
        int r = it;
        if (r < I_IN) { const int kb = r / 160, nb = r % 160; const int d0 = nb * 32;
            const int n0 = d0 < 1280 ? d0 : (d0 < 4864 ? d0 + 24 : (d0 == 4864 ? 1280 : -1));
            transpose_item(in.p[2], 1024, IN_COLS, n0, nullptr, (bf16*)(ws + WS_WIN), d0, scr, kb, F.lane); continue; } r -= I_IN;
        if (r < I_UP) { transpose_item(in.p[12], 512, 1024, (r % 32) * 32, nullptr, (bf16*)(ws + WS_WN), (r % 32) * 32, scr, r / 32, F.lane); continue; } r -= I_UP;
        if (r < I_UP) { transpose_item(in.p[13], 512, 1024, (r % 32) * 32, nullptr, (bf16*)(ws + WS_WSB), (r % 32) * 32, scr, r / 32, F.lane); continue; } r -= I_UP;
        if (r < I_O) { transpose_item(in.p[14], 1024, 1024, (r % 32) * 32, nullptr, (bf16*)(ws + WS_WO), (r % 32) * 32, scr, r / 32, F.lane); continue; } r -= I_O;
        if (r < I_1) { transpose_item(in.p[16], 1024, 4096, (r % 128) * 32, in.p[15], (bf16*)(ws + WS_W1), (r % 128) * 32, scr, r / 128, F.lane); continue; } r -= I_1;
        if (r < I_2) { transpose_item(in.p[17], 4096, 1024, (r % 32) * 32, nullptr, (bf16*)(ws + WS_W2), (r % 32) * 32, scr, r / 32, F.lane); continue; } r -= I_2;
        if (r < I_C1) { transpose_item(in.p[5], 2048, 256, (r % 8) * 32, nullptr, (bf16*)(ws + WS_CW1K), (r % 8) * 32, scr, r / 8, F.lane); continue; } r -= I_C1;
        if (r < I_C1) { transpose_item(in.p[9], 2048, 256, (r % 8) * 32, nullptr, (bf16*)(ws + WS_CW1V), (r % 8) * 32, scr, r / 8, F.lane); continue; } r -= I_C1;
        if (r < I_C2) { transpose_item(in.p[7], 256, 64, (r % 2) * 32, nullptr, (bf16*)(ws + WS_CW2K), (r % 2) * 32, scr, r / 2, F.lane); continue; } r -= I_C2;
        transpose_item(in.p[11], 256, 64, (r % 2) * 32, nullptr, (bf16*)(ws + WS_CW2V), (r % 2) * 32, scr, r / 2, F.lane);
    }
    bf16* XN = (bf16*)(ws + WS_XN);
    for (int m = gw; m < M; m += NGW) rms_row_to_bf16(F.lane, in.p[0] + (size_t)m * DM, in.p[1], XN + (size_t)m * DM);
}

__device__ __forceinline__ v4u pack8(const f32x4 a, const f32x4 b) { v4u w; w.x = cvtpk(a[0], a[1]); w.y = cvtpk(a[2], a[3]); w.z = cvtpk(b[0], b[1]); w.w = cvtpk(b[2], b[3]); return w; }
__device__ __forceinline__ f32x4 sig4(const f32x4 a) { f32x4 r; r[0] = fast_sigmoid(a[0]); r[1] = fast_sigmoid(a[1]); r[2] = fast_sigmoid(a[2]); r[3] = fast_sigmoid(a[3]); return r; }

struct EpiInProj {
    static constexpr bool PERM = true, AFTER_DRAIN = false;
    bf16 *QN, *KV, *SB, *GM; float* GN;
    __device__ __forceinline__ void operator()(const f32x4 (&acc)[2][2][4][2], const pg8::Unit& u, int wr, int wc, int fr, int fq) const {
        const int row0 = u.pm * 256 + wr * 64 + fr;
#pragma unroll
        for (int bj = 0; bj < 2; ++bj) {
            const int cb = u.pn * 256 + bj * 128;
            const int c = cb + wc * 32 + 8 * fq;
#pragma unroll
            for (int ai = 0; ai < 2; ++ai)
#pragma unroll
                for (int m = 0; m < 4; ++m) {
                    const int row = row0 + ai * 128 + m * 16; const int b = row >> 11, t = row & 2047;
                    f32x4 v0 = acc[ai][bj][m][0], v1 = acc[ai][bj][m][1];
                    if (cb < 512) { v0 = v0 * QSCALE; v1 = v1 * QSCALE; *(GAS v4u*)(QN + (size_t)row * 512 + c) = pack8(v0, v1); }
                    else if (cb < 1280) { const int cc = c - 512, a = cc >> 7, g = (cc >> 6) & 1, d = cc & 63;
                        *(GAS v4u*)(KV + ((((size_t)a * BATCH + b) * 2 + g) * SEQ + t) * 64 + d) = pack8(v0, v1); }
                    else if (cb < 2816) { const int cc = c - 1280, wh = cc >> 9, h = (cc >> 6) & 7, d = cc & 63;
                        if (wh == 0) { v0 = v0 * QSCALE; v1 = v1 * QSCALE; }
                        *(GAS v4u*)(SB + ((((size_t)wh * BATCH + b) * 8 + h) * SEQ + t) * 64 + d) = pack8(v0, v1); }
                    else if (cb < 4864) { *(GAS v4u*)(GM + (size_t)row * 2048 + (c - 2816)) = pack8(sig4(v0), sig4(v1)); }
                    else { const int cc = c - 4864; if (cc < 24) { GAS f32x4* o = (GAS f32x4*)(GN + (size_t)row * 24 + cc); o[0] = sig4(v0); o[1] = sig4(v1); } }
                }
        }
    }
};
template <bool SECOND> struct EpiUp {
    static constexpr bool PERM = true, AFTER_DRAIN = false;
    bf16* MIX; const bf16* GMg;
    __device__ __forceinline__ void operator()(const f32x4 (&acc)[2][2][4][2], const pg8::Unit& u, int wr, int wc, int fr, int fq) const {
        const int row0 = u.pm * 256 + wr * 64 + fr;
#pragma unroll
        for (int ai = 0; ai < 2; ++ai)
#pragma unroll
            for (int m = 0; m < 4; ++m) { const int row = row0 + ai * 128 + m * 16;
#pragma unroll
                for (int bj = 0; bj < 2; ++bj) { const int c = u.pn * 256 + bj * 128 + wc * 32 + 8 * fq;
                    const v4u gw = *(const GAS v4u*)(GMg + (size_t)row * 2048 + c);
                    float r[8];
#pragma unroll
                    for (int q = 0; q < 4; ++q) { r[2 * q] = __builtin_bit_cast(float, gw[q] << 16); r[2 * q + 1] = __builtin_bit_cast(float, gw[q] & 0xffff0000u); }
                    f32x4 v0 = acc[ai][bj][m][0], v1 = acc[ai][bj][m][1];
#pragma unroll
                    for (int q = 0; q < 4; ++q) { v0[q] *= r[q]; v1[q] *= r[4 + q]; }
                    GAS v4u* dst = (GAS v4u*)(MIX + (size_t)row * 1024 + c);
                    if (SECOND) { const v4u pw = *dst;
#pragma unroll
                        for (int q = 0; q < 2; ++q) { v0[2 * q] += __builtin_bit_cast(float, pw[q] << 16); v0[2 * q + 1] += __builtin_bit_cast(float, pw[q] & 0xffff0000u);
                                                      v1[2 * q] += __builtin_bit_cast(float, pw[2 + q] << 16); v1[2 * q + 1] += __builtin_bit_cast(float, pw[2 + q] & 0xffff0000u); } }
                    *dst = pack8(v0, v1); } }
    }
};
struct EpiOut {
    static constexpr bool PERM = true, AFTER_DRAIN = false;
    const float* X; float* X1; bf16* X1B; float* rowss;
    __device__ __forceinline__ void operator()(const f32x4 (&acc)[2][2][4][2], const pg8::Unit& u, int wr, int wc, int fr, int fq) const {
        const int row0 = u.pm * 256 + wr * 64 + fr;
#pragma unroll
        for (int ai = 0; ai < 2; ++ai)
#pragma unroll
            for (int m = 0; m < 4; ++m) { const int row = row0 + ai * 128 + m * 16; float ss = 0.f;
#pragma unroll
                for (int bj = 0; bj < 2; ++bj) { const int c = u.pn * 256 + bj * 128 + wc * 32 + 8 * fq; const size_t off = (size_t)row * 1024 + c;
                    const f32x4 x0 = *(const GAS f32x4*)(X + off), x1 = *(const GAS f32x4*)(X + off + 4);
                    const f32x4 y0 = x0 + acc[ai][bj][m][0], y1 = x1 + acc[ai][bj][m][1];
                    *(GAS f32x4*)(X1 + off) = y0; *(GAS f32x4*)(X1 + off + 4) = y1; *(GAS v4u*)(X1B + off) = pack8(y0, y1);
                    ss += (y0[0] * y0[0] + y0[1] * y0[1]) + (y0[2] * y0[2] + y0[3] * y0[3]) + (y1[0] * y1[0] + y1[1] * y1[1]) + (y1[2] * y1[2] + y1[3] * y1[3]); }
                ss += __shfl_xor(ss, 16); ss += __shfl_xor(ss, 32);
                if (fq == 0) atomicAdd(rowss + row, ss); }
    }
};
struct EpiFF1 {
    static constexpr bool PERM = true, AFTER_DRAIN = false;
    bf16* Fo; const float* rowss;
    __device__ __forceinline__ void operator()(const f32x4 (&acc)[2][2][4][2], const pg8::Unit& u, int wr, int wc, int fr, int fq) const {
        const int row0 = u.pm * 256 + wr * 64 + fr;
#pragma unroll
        for (int ai = 0; ai < 2; ++ai)
#pragma unroll
            for (int m = 0; m < 4; ++m) { const int row = row0 + ai * 128 + m * 16;
                const float rs2 = 1.0f / (rowss[row] * (1.0f / DM) + EPS);
#pragma unroll
                for (int bj = 0; bj < 2; ++bj) { const int c = u.pn * 256 + bj * 128 + wc * 32 + 8 * fq;
                    f32x4 v0 = acc[ai][bj][m][0], v1 = acc[ai][bj][m][1];
#pragma unroll
                    for (int q = 0; q < 4; ++q) { const float a = fmaxf(v0[q], 0.f), b = fmaxf(v1[q], 0.f); v0[q] = a * a * rs2; v1[q] = b * b * rs2; }
                    *(GAS v4u*)(Fo + (size_t)row * FF + c) = pack8(v0, v1); } }
    }
};
struct EpiFF2 {
    static constexpr bool PERM = true, AFTER_DRAIN = false;
    float* X1;
    __device__ __forceinline__ void operator()(const f32x4 (&acc)[2][2][4][2], const pg8::Unit& u, int wr, int wc, int fr, int fq) const {
        const int row0 = u.pm * 256 + wr * 64 + fr;
#pragma unroll
        for (int ai = 0; ai < 2; ++ai)
#pragma unroll
            for (int m = 0; m < 4; ++m) { const int row = row0 + ai * 128 + m * 16;
#pragma unroll
                for (int bj = 0; bj < 2; ++bj) { const int c = u.pn * 256 + bj * 128 + wc * 32 + 8 * fq; GAS f32x4* p = (GAS f32x4*)(X1 + (size_t)row * 1024 + c);
                    p[0] = p[0] + acc[ai][bj][m][0]; p[1] = p[1] + acc[ai][bj][m][1]; } }
    }
};

namespace att {
typedef short v4i16_t __attribute__((ext_vector_type(4)));
constexpr int L_K0 = 0, L_K1 = 8192, L_V0 = 16384, L_V1 = 24576, L_BIAS = 32768, L_IMP = 36864, L_SELM = 45056, L_WMASK = 45312, L_DONE = 45376, L_HID = 49152;
__device__ __forceinline__ int crow(int r, int hi) { return (r & 3) + 8 * (r >> 2) + 4 * hi; }
__device__ __forceinline__ s16x4 vtr(const LAS unsigned char* p) { return __builtin_bit_cast(s16x4, __builtin_amdgcn_ds_read_tr16_b64_v4i16((LAS v4i16_t*)p)); }
__device__ __forceinline__ float swapmax(float v) { auto rr = __builtin_amdgcn_permlane32_swap(__float_as_uint(v), __float_as_uint(v), false, false); return fmaxf(__uint_as_float(rr[0]), __uint_as_float(rr[1])); }
__device__ __forceinline__ float swapsum(float v) { auto rr = __builtin_amdgcn_permlane32_swap(__float_as_uint(v), __float_as_uint(v), false, false); return __uint_as_float(rr[0]) + __uint_as_float(rr[1]); }

__device__ __forceinline__ v4u ld_piece(const bf16* g, int tid) { return *(const GAS v4u*)((const GAS char*)g + tid * 16); }
__device__ __forceinline__ void st_kimg(LAS unsigned char* K, int tid, v4u v) { const int key = tid >> 3, ch = tid & 7; *(LAS v4u*)(K + ch * 1024 + key * 16) = v; }
__device__ __forceinline__ void st_vimg(LAS unsigned char* V, int tid, v4u v) { const int key = tid >> 3, c8 = tid & 7; *(LAS v4u*)(V + ((c8 >> 2) * 4 + (key >> 4)) * 1024 + (key & 15) * 64 + (c8 & 3) * 16) = v; }

__device__ __forceinline__ void qkt(f32x16& p0, f32x16& p1, const LAS unsigned char* Kimg, const bf16x8 (&qr)[4], int r32, int hi) {
    const LAS unsigned char* kb = Kimg + hi * 1024 + r32 * 16;
    f32x16 a = {}, b = {};
#pragma unroll
    for (int d0 = 0; d0 < 4; ++d0) {
        const bf16x8 k0 = *(const LAS bf16x8*)(kb + d0 * 2048);
        const bf16x8 k1 = *(const LAS bf16x8*)(kb + d0 * 2048 + 512);
        a = __builtin_amdgcn_mfma_f32_32x32x16_bf16(k0, qr[d0], a, 0, 0, 0);
        b = __builtin_amdgcn_mfma_f32_32x32x16_bf16(k1, qr[d0], b, 0, 0, 0);
    }
    p0 = a; p1 = b;
}
__device__ __forceinline__ void pv(f32x16 (&o)[2], const LAS unsigned char* Vimg, int lane, const f32x16& p0, const f32x16& p1) {
    const int hi = lane >> 5;
    const LAS unsigned char* vb = Vimg + ((lane >> 4) & 1) * 32 + (lane & 3) * 8 + (4 * hi + ((lane & 15) >> 2)) * 64;
    bf16x8 pa[4];
    { v4u w;
      w.x = cvtpk(p0[0], p0[1]); w.y = cvtpk(p0[2], p0[3]); w.z = cvtpk(p0[4], p0[5]); w.w = cvtpk(p0[6], p0[7]); pa[0] = __builtin_bit_cast(bf16x8, w);
      w.x = cvtpk(p0[8], p0[9]); w.y = cvtpk(p0[10], p0[11]); w.z = cvtpk(p0[12], p0[13]); w.w = cvtpk(p0[14], p0[15]); pa[1] = __builtin_bit_cast(bf16x8, w);
      w.x = cvtpk(p1[0], p1[1]); w.y = cvtpk(p1[2], p1[3]); w.z = cvtpk(p1[4], p1[5]); w.w = cvtpk(p1[6], p1[7]); pa[2] = __builtin_bit_cast(bf16x8, w);
      w.x = cvtpk(p1[8], p1[9]); w.y = cvtpk(p1[10], p1[11]); w.z = cvtpk(p1[12], p1[13]); w.w = cvtpk(p1[14], p1[15]); pa[3] = __builtin_bit_cast(bf16x8, w); }
#pragma unroll
    for (int dh = 0; dh < 2; ++dh)
#pragma unroll
        for (int ks = 0; ks < 4; ++ks) {
            const s16x4 lo = vtr(vb + dh * 4096 + ks * 1024), hh = vtr(vb + dh * 4096 + ks * 1024 + 512);
            const bf16x8 vf = (bf16x8){lo[0], lo[1], lo[2], lo[3], hh[0], hh[1], hh[2], hh[3]};
            o[dh] = __builtin_amdgcn_mfma_f32_32x32x16_bf16(vf, pa[ks], o[dh], 0, 0, 0);
        }
}
__device__ __forceinline__ void softmax_pv(f32x16& p0, f32x16& p1, float& m, float& l, f32x16 (&o)[2], const LAS unsigned char* Vimg, int lane) {
    float rm = fmaxf(p0[0], p1[0]);
#pragma unroll
    for (int r = 1; r < 16; ++r) rm = fmaxf(rm, fmaxf(p0[r], p1[r]));
    rm = swapmax(rm);
    const float mn = fmaxf(m, rm), f = fast_exp2(m - mn); m = mn; l *= f;
#pragma unroll
    for (int r = 0; r < 16; ++r) { o[0][r] *= f; o[1][r] *= f; }
    float s = 0.f;
#pragma unroll
    for (int r = 0; r < 16; ++r) { p0[r] = fast_exp2(p0[r] - mn); p1[r] = fast_exp2(p1[r] - mn); s += p0[r] + p1[r]; }
    l += s;
    pv(o, Vimg, lane, p0, p1);
}
__device__ __forceinline__ void stage_kv(LAS unsigned char* Kimg, LAS unsigned char* Vimg, const bf16* kg, const bf16* vg, int tid) {
    const v4u a = ld_piece(kg, tid), b = ld_piece(vg, tid);
    st_kimg(Kimg, tid, a); st_vimg(Vimg, tid, b);
}
__device__ __forceinline__ void acc_out(f32x16 (&oacc)[2], const f32x16 (&o)[2], float sc) {
#pragma unroll
    for (int r = 0; r < 16; ++r) { oacc[0][r] += o[0][r] * sc; oacc[1][r] += o[1][r] * sc; }
}
__device__ __forceinline__ void store_o(bf16* dst, const f32x16 (&o)[2], int hi) {
#pragma unroll
    for (int dh = 0; dh < 2; ++dh)
#pragma unroll
        for (int i = 0; i < 4; ++i) { v2u w; w.x = cvtpk(o[dh][4 * i], o[dh][4 * i + 1]); w.y = cvtpk(o[dh][4 * i + 2], o[dh][4 * i + 3]);
            *(GAS v2u*)(dst + 32 * dh + 8 * i + 4 * hi) = w; }
}

__device__ __forceinline__ void nsa_unit(Frame& F, unsigned char* ws, const float* rel_bias, int b, int g, int j) {
    LAS unsigned char* lds = F.lds;
    const int tid = F.tid, lane = F.lane, w = F.wave, r32 = lane & 31, hi = lane >> 5;
    const int tl = r32 >> 2, hd = r32 & 3, tokl = 8 * w + tl, t = 64 * j + tokl, head = 4 * g + hd;
    const size_t row = (size_t)b * SEQ + t;
    const bf16* QN = (const bf16*)(ws + WS_QN); const bf16* KV = (const bf16*)(ws + WS_KV); const float* GN = (const float*)(ws + WS_GN);
    LAS float* biasS = (LAS float*)(lds + L_BIAS); LAS float* impS = (LAS float*)(lds + L_IMP) + w * 256; LAS unsigned* selm = (LAS unsigned*)(lds + L_SELM) + w * 8;
    LAS unsigned* wmask = (LAS unsigned*)(lds + L_WMASK);
    __syncthreads();
    for (int i = tid; i < 4 * 129; i += 512) { const int h = i / 129, d = i % 129; biasS[h * 132 + d] = rel_bias[T5B[d] * 8 + 4 * g + h] * LOG2E; }
    { const bf16* kc = (const bf16*)(ws + WS_KC) + (size_t)(b * 2 + g) * 128 * 64; const bf16* vc = (const bf16*)(ws + WS_VC) + (size_t)(b * 2 + g) * 128 * 64;
      stage_kv(lds + L_K0, lds + L_V0, kc, vc, tid); stage_kv(lds + L_K1, lds + L_V1, kc + 4096, vc + 4096, tid); }
    bf16x8 qr[4];
    { const bf16* qp = QN + row * 512 + head * 64;
#pragma unroll
      for (int d0 = 0; d0 < 4; ++d0) qr[d0] = *(const GAS bf16x8*)(qp + 16 * d0 + 8 * hi); }
    const float g_cmp = GN[row * 24 + head * 3 + 0], g_sel = GN[row * 24 + head * 3 + 1], g_win = GN[row * 24 + head * 3 + 2];
    __syncthreads();
    const LAS float* bh = biasS + hd * 132;
    const float bias_far = bh[128];
    f32x16 oacc[2]; oacc[0] = f32x16{}; oacc[1] = f32x16{};
    {
        f32x16 s[4];
        qkt(s[0], s[1], lds + L_K0, qr, r32, hi); qkt(s[2], s[3], lds + L_K1, qr, r32, hi);
        float mx = NEGBIG;
#pragma unroll
        for (int q = 0; q < 4; ++q)
#pragma unroll
            for (int r = 0; r < 16; ++r) { const int c = 32 * q + crow(r, hi); const int dist = t - 16 * c - 31;
                const float bv = bh[dist > 128 ? 128 : (dist < 0 ? 0 : dist)];
                const float v = dist >= 0 ? s[q][r] + bv : NEGBIG; s[q][r] = v; mx = fmaxf(mx, v); }
        mx = swapmax(mx);
        const bool anyv = mx > -1e29f;
        float sum = 0.f;
#pragma unroll
        for (int q = 0; q < 4; ++q)
#pragma unroll
            for (int r = 0; r < 16; ++r) { const float p = anyv ? fast_exp2(s[q][r] - mx) : 0.f; s[q][r] = p; sum += p; }
        sum = swapsum(sum);
        const float inv = anyv ? 1.0f / sum : 0.f;
#pragma unroll
        for (int q = 0; q < 4; ++q)
#pragma unroll
            for (int r = 0; r < 16; ++r) s[q][r] *= inv;
        float G[16], last[16];
#pragma unroll
        for (int q = 0; q < 4; ++q)
#pragma unroll
            for (int i = 0; i < 4; ++i) { G[4 * q + i] = (s[q][4 * i] + s[q][4 * i + 1]) + (s[q][4 * i + 2] + s[q][4 * i + 3]); last[4 * q + i] = s[q][4 * i + 3]; }
        float val[16];
#pragma unroll
        for (int u = 0; u < 16; ++u) {
            auto rr = __builtin_amdgcn_permlane32_swap(__float_as_uint(last[u]), __float_as_uint(last[u]), false, false);
            const float l0 = __uint_as_float(rr[0]);
            float prev1 = 0.f;
            if (u > 0) { auto r2 = __builtin_amdgcn_permlane32_swap(__float_as_uint(last[u - 1]), __float_as_uint(last[u - 1]), false, false); prev1 = __uint_as_float(r2[1]); }
            val[u] = G[u] + (hi ? l0 : prev1);
        }
#pragma unroll
        for (int u = 0; u < 16; ++u) { val[u] += __shfl_xor(val[u], 1); val[u] += __shfl_xor(val[u], 2); }
        if (hd == 0) {
#pragma unroll
            for (int u = 0; u < 16; ++u) impS[tl * 32 + 2 * u + hi] = val[u];
        }
        f32x16 o[2]; o[0] = f32x16{}; o[1] = f32x16{};
        pv(o, lds + L_V0, lane, s[0], s[1]); pv(o, lds + L_V1, lane, s[2], s[3]);
        acc_out(oacc, o, g_cmp);
    }
    asm volatile("s_waitcnt lgkmcnt(0)" ::: "memory"); __builtin_amdgcn_wave_barrier();
    if (lane < 8) {
        unsigned mask = 1u | (1u << j);
        float b1 = -1.f, b2 = -1.f; int i1 = -1, i2 = -1;
        for (int n = 1; n < j; ++n) { const float v = impS[lane * 32 + n];
            if (v > b1) { b2 = b1; i2 = i1; b1 = v; i1 = n; } else if (v > b2) { b2 = v; i2 = n; } }
        if (i1 >= 0) mask |= 1u << i1;
        if (i2 >= 0) mask |= 1u << i2;
        selm[lane] = mask;
    }
    asm volatile("s_waitcnt lgkmcnt(0)" ::: "memory"); __builtin_amdgcn_wave_barrier();
    const unsigned mymask = selm[tl];
    unsigned wm = mymask;
#pragma unroll
    for (int o_ = 1; o_ < 64; o_ <<= 1) wm |= (unsigned)__shfl_xor((int)wm, o_);
    if (lane == 0) wmask[w] = wm;
    __syncthreads();
    unsigned um = 0;
#pragma unroll
    for (int i = 0; i < 8; ++i) um |= wmask[i];
    um = (unsigned)__builtin_amdgcn_readfirstlane((int)um);
    wm = (unsigned)__builtin_amdgcn_readfirstlane((int)wm);
    {
        const bf16* ks = KV + 2 * KVARR + (size_t)(b * 2 + g) * SEQ * 64; const bf16* vs = KV + 3 * KVARR + (size_t)(b * 2 + g) * SEQ * 64;
        float m = NEGBIG, l = 0.f; f32x16 o[2]; o[0] = f32x16{}; o[1] = f32x16{};
        for (int n = 0; n <= j; ++n) {
            if (!((um >> n) & 1u)) continue;
            __syncthreads();
            stage_kv(lds + L_K0, lds + L_V0, ks + (size_t)n * 4096, vs + (size_t)n * 4096, tid);
            __syncthreads();
            if ((wm >> n) & 1u) {
                f32x16 p0, p1; qkt(p0, p1, lds + L_K0, qr, r32, hi);
                const bool sel = (mymask >> n) & 1u;
                const int dbase = t - 64 * n - 4 * hi;
                if (j - n >= 3) {
#pragma unroll
                    for (int r = 0; r < 16; ++r) { p0[r] = sel ? p0[r] + bias_far : NEGBIG; p1[r] = sel ? p1[r] + bias_far : NEGBIG; }
                } else {
#pragma unroll
                    for (int r = 0; r < 16; ++r) { const int d0 = dbase - ((r & 3) + 8 * (r >> 2)), d1 = d0 - 32;
                        const float b0 = bh[d0 > 128 ? 128 : (d0 < 0 ? 0 : d0)], b1_ = bh[d1 > 128 ? 128 : (d1 < 0 ? 0 : d1)];
                        p0[r] = (sel && d0 >= 0) ? p0[r] + b0 : NEGBIG; p1[r] = (sel && d1 >= 0) ? p1[r] + b1_ : NEGBIG; }
                }
                softmax_pv(p0, p1, m, l, o, lds + L_V0, lane);
            }
        }
        l = swapsum(l);
        acc_out(oacc, o, g_sel / l);
    }
    {
        const bf16* kw = KV + 4 * KVARR + (size_t)(b * 2 + g) * SEQ * 64; const bf16* vw = KV + 5 * KVARR + (size_t)(b * 2 + g) * SEQ * 64;
        float m = NEGBIG, l = 0.f; f32x16 o[2]; o[0] = f32x16{}; o[1] = f32x16{};
        const int jt0 = j >= 8 ? j - 8 : 0;
        for (int jt = jt0; jt <= j; ++jt) {
            __syncthreads();
            stage_kv(lds + L_K0, lds + L_V0, kw + (size_t)jt * 4096, vw + (size_t)jt * 4096, tid);
            __syncthreads();
            f32x16 p0, p1; qkt(p0, p1, lds + L_K0, qr, r32, hi);
            const int dbase = t - 64 * jt - 4 * hi;
            if (j - jt >= 3 && j - jt < 8) {
#pragma unroll
                for (int r = 0; r < 16; ++r) { p0[r] += bias_far; p1[r] += bias_far; }
            } else {
#pragma unroll
                for (int r = 0; r < 16; ++r) { const int d0 = dbase - ((r & 3) + 8 * (r >> 2)), d1 = d0 - 32;
                    const float b0 = bh[d0 > 128 ? 128 : (d0 < 0 ? 0 : d0)], b1_ = bh[d1 > 128 ? 128 : (d1 < 0 ? 0 : d1)];
                    p0[r] = (d0 >= 0 && d0 < 512) ? p0[r] + b0 : NEGBIG; p1[r] = (d1 >= 0 && d1 < 512) ? p1[r] + b1_ : NEGBIG; }
            }
            softmax_pv(p0, p1, m, l, o, lds + L_V0, lane);
        }
        l = swapsum(l);
        acc_out(oacc, o, g_win / l);
    }
    store_o((bf16*)(ws + WS_ONSA) + row * 512 + head * 64, oacc, hi);
}

__device__ __forceinline__ void sb_unit(Frame& F, unsigned char* ws, int b, int h, int qb) {
    LAS unsigned char* lds = F.lds;
    const int tid = F.tid, lane = F.lane, w = F.wave, r32 = lane & 31, hi = lane >> 5;
    const int t = 256 * qb + 32 * w + r32;
    const bf16* SBQ = (const bf16*)(ws + WS_SB) + (size_t)(b * 8 + h) * SEQ * 64; const bf16* SBK = SBQ + SBARR; const bf16* SBV = SBQ + 2 * SBARR;
    LAS unsigned* donef = (LAS unsigned*)(lds + L_DONE);
    bf16x8 qr[4];
#pragma unroll
    for (int d0 = 0; d0 < 4; ++d0) qr[d0] = *(const GAS bf16x8*)(SBQ + (size_t)t * 64 + 16 * d0 + 8 * hi);
    f32x16 o[2]; o[0] = f32x16{}; o[1] = f32x16{};
    float C = 0.f;
    bool done = false;
    const int ktop = 4 * qb + 3, kmine = 4 * qb + (w >> 1);
    for (int kt = ktop; kt >= 0; --kt) {
        __syncthreads();
        if (lane == 0) donef[w] = done ? 1u : 0u;
        stage_kv(lds + L_K0, lds + L_V0, SBK + (size_t)kt * 4096, SBV + (size_t)kt * 4096, tid);
        __syncthreads();
        unsigned nd = 0;
#pragma unroll
        for (int i = 0; i < 8; ++i) nd += donef[i];
        if (__builtin_amdgcn_readfirstlane((int)nd) == 8) break;
        if (done || kt > kmine) continue;
        f32x16 z0, z1; qkt(z0, z1, lds + L_K0, qr, r32, hi);
        const int kb0 = 64 * kt + 4 * hi;
        f32x16 lb0, lb1;
#pragma unroll
        for (int r = 0; r < 16; ++r) {
            { const float z = z0[r], e = fast_exp2(-fabsf(z)), L = __builtin_amdgcn_logf(1.0f + e); const bool ok = kb0 + (r & 3) + 8 * (r >> 2) < t;
              lb0[r] = fminf(z, 0.f) - L; z0[r] = ok ? -fmaxf(z, 0.f) - L : 0.f; if (!ok) lb0[r] = NEGBIG; }
            { const float z = z1[r], e = fast_exp2(-fabsf(z)), L = __builtin_amdgcn_logf(1.0f + e); const bool ok = kb0 + 32 + (r & 3) + 8 * (r >> 2) < t;
              lb1[r] = fminf(z, 0.f) - L; z1[r] = ok ? -fmaxf(z, 0.f) - L : 0.f; if (!ok) lb1[r] = NEGBIG; }
        }
        float gs[8];
#pragma unroll
        for (int i = 0; i < 4; ++i) { gs[i] = (z0[4 * i] + z0[4 * i + 1]) + (z0[4 * i + 2] + z0[4 * i + 3]); gs[4 + i] = (z1[4 * i] + z1[4 * i + 1]) + (z1[4 * i + 2] + z1[4 * i + 3]); }
        float E[8]; float run = 0.f;
#pragma unroll
        for (int u = 7; u >= 0; --u) {
            auto rr = __builtin_amdgcn_permlane32_swap(__float_as_uint(gs[u]), __float_as_uint(gs[u]), false, false);
            const float g0 = __uint_as_float(rr[0]), g1 = __uint_as_float(rr[1]);
            const float e1 = run; run += g1; const float e0 = run; run += g0;
            E[u] = hi ? e1 : e0;
        }
#pragma unroll
        for (int i = 0; i < 4; ++i) {
            { float later = C + E[i];
              const float a3 = fast_exp2(lb0[4 * i + 3] + later); later += z0[4 * i + 3];
              const float a2 = fast_exp2(lb0[4 * i + 2] + later); later += z0[4 * i + 2];
              const float a1 = fast_exp2(lb0[4 * i + 1] + later); later += z0[4 * i + 1];
              const float a0 = fast_exp2(lb0[4 * i] + later);
              z0[4 * i] = a0; z0[4 * i + 1] = a1; z0[4 * i + 2] = a2; z0[4 * i + 3] = a3; }
            { float later = C + E[4 + i];
              const float a3 = fast_exp2(lb1[4 * i + 3] + later); later += z1[4 * i + 3];
              const float a2 = fast_exp2(lb1[4 * i + 2] + later); later += z1[4 * i + 2];
              const float a1 = fast_exp2(lb1[4 * i + 1] + later); later += z1[4 * i + 1];
              const float a0 = fast_exp2(lb1[4 * i] + later);
              z1[4 * i] = a0; z1[4 * i + 1] = a1; z1[4 * i + 2] = a2; z1[4 * i + 3] = a3; }
        }
        C += run;
        pv(o, lds + L_V0, lane, z0, z1);
        done = __all(C < -151.0f);
    }
    store_o((bf16*)(ws + WS_OSB) + ((size_t)b * SEQ + t) * 512 + h * 64, o, hi);
}

__device__ __forceinline__ float gelu_tanh(float x) {
    const float u = 0.7978845608028654f * (x + 0.044715f * x * x * x);
    const float e = fast_exp2(2.0f * LOG2E * u);
    const float th = 1.0f - 2.0f * __builtin_amdgcn_rcpf(e + 1.0f);
    return 0.5f * x * (1.0f + th);
}
__device__ __forceinline__ void cmp_unit(Frame& F, unsigned char* ws, const float* pe, const float* b1, int kv, int b, int g, int cc) {
    LAS unsigned char* lds = F.lds;
    const int lane = F.lane, w = F.wave, r32 = lane & 31, hi = lane >> 5;
    const bf16* src = (const bf16*)(ws + WS_KV) + (size_t)kv * KVARR + (size_t)(b * 2 + g) * SEQ * 64;
    const bf16* W1T = (const bf16*)(ws + (kv ? WS_CW1V : WS_CW1K)); const bf16* W2T = (const bf16*)(ws + (kv ? WS_CW2V : WS_CW2K));
    bf16* dst = (bf16*)(ws + (kv ? WS_VC : WS_KC)) + (size_t)(b * 2 + g) * 128 * 64;
    LAS bf16* hid = (LAS bf16*)(lds + L_HID);
    const int c = 32 * cc + r32;
    f32x16 acc = {};
    const bf16* arow = src + (size_t)(16 * c) * 64 + 8 * hi;
    const bf16* brow = W1T + (size_t)(32 * w + r32) * 2048 + 8 * hi;
    const float* perow = pe + 8 * hi;
#pragma unroll 4
    for (int ks = 0; ks < 128; ++ks) {
        const v4u a = *(const GAS v4u*)(arow + 16 * ks);
        const f32x4 e0 = *(const GAS f32x4*)(perow + 16 * ks), e1 = *(const GAS f32x4*)(perow + 16 * ks + 4);
        const bf16x8 bf = *(const GAS bf16x8*)(brow + 16 * ks);
        v4u aw;
        aw.x = cvtpk(__builtin_bit_cast(float, a.x << 16) + e0[0], __builtin_bit_cast(float, a.x & 0xffff0000u) + e0[1]);
        aw.y = cvtpk(__builtin_bit_cast(float, a.y << 16) + e0[2], __builtin_bit_cast(float, a.y & 0xffff0000u) + e0[3]);
        aw.z = cvtpk(__builtin_bit_cast(float, a.z << 16) + e1[0], __builtin_bit_cast(float, a.z & 0xffff0000u) + e1[1]);
        aw.w = cvtpk(__builtin_bit_cast(float, a.w << 16) + e1[2], __builtin_bit_cast(float, a.w & 0xffff0000u) + e1[3]);
        acc = __builtin_amdgcn_mfma_f32_32x32x16_bf16(__builtin_bit_cast(bf16x8, aw), bf, acc, 0, 0, 0);
    }
    __syncthreads();
    { const float bias = b1[32 * w + r32];
#pragma unroll
      for (int r = 0; r < 16; ++r) hid[crow(r, hi) * 264 + 32 * w + r32] = (bf16)f2bf(gelu_tanh(acc[r] + bias)); }
    __syncthreads();
    if (w < 2) {
        f32x16 o = {};
        const LAS bf16* hrow = hid + r32 * 264 + 8 * hi;
        const bf16* w2row = W2T + (size_t)(32 * w + r32) * 256 + 8 * hi;
#pragma unroll
        for (int ks = 0; ks < 16; ++ks) {
            const bf16x8 af = *(const LAS bf16x8*)(hrow + 16 * ks);
            const bf16x8 bf = *(const GAS bf16x8*)(w2row + 16 * ks);
            o = __builtin_amdgcn_mfma_f32_32x32x16_bf16(af, bf, o, 0, 0, 0);
        }
#pragma unroll
        for (int r = 0; r < 16; ++r) { const int cr = 32 * cc + crow(r, hi); dst[(size_t)cr * 64 + 32 * w + r32] = (bf16)(cr < 127 ? f2bf(o[r]) : 0u); }
    }
}
}

__device__ __forceinline__ void final_norm_row(int lane, float* xrow, const float* g) {
    GAS f32x4* xr = (GAS f32x4*)xrow + lane; const GAS f32x4* gr = (const GAS f32x4*)g + lane;
    f32x4 v[4]; float s = 0.f;
#pragma unroll
    for (int j = 0; j < 4; ++j) { v[j] = xr[64 * j]; s += (v[j].x * v[j].x + v[j].y * v[j].y) + (v[j].z * v[j].z + v[j].w * v[j].w); }
    const float rstd = 1.f / sqrtf(wave_sum(s) * (1.f / DM) + EPS);
#pragma unroll
    for (int j = 0; j < 4; ++j) { const f32x4 gg = gr[64 * j]; xr[64 * j] = v[j] * rstd * gg; }
}

struct Args { In in; float* out; unsigned char* ws; int ph_lo, ph_hi, li, pad; };
__global__ void __launch_bounds__(NWAVES * 64, 2) fwd_kernel(Args args) {
    extern __shared__ __attribute__((aligned(16))) unsigned char lds[];
    Frame F;
    F.lds = (LAS unsigned char*)lds;
    F.MISC = (volatile LAS unsigned*)(F.lds + MISC_OFF);
    F.tid = threadIdx.x; F.lane = F.tid & 63; F.wave = __builtin_amdgcn_readfirstlane(F.tid >> 6);
    F.G = gridDim.x; { const int bx = blockIdx.x; F.vcu = (F.G % 8 == 0) ? (bx % 8) * (F.G / 8) + bx / 8 : bx; }
    unsigned char* ws = args.ws;
    F.ctl = (gu32*)(ws + WS_CTL);
    for (int u = F.tid; u < (LDS_BYTES - LDSCTL_OFF) / 4; u += NWAVES * 64) ((LAS unsigned*)(F.lds + LDSCTL_OFF))[u] = 0u;
    __syncthreads();
    constexpr bool PER_PHASE = (MK_N_LAUNCHES != 1);
    XcdBarrier bar; bar.bar = (unsigned*)(F.ctl + CW_BAR); bar.x = 0; bar.st = nullptr;
    if (!PER_PHASE) bar = xcd_barrier_post((unsigned*)(F.ctl + CW_BAR), F.MISC + 8);
#define GRID_BAR() do { if (!PER_PHASE) xcd_barrier(bar); } while (0)
    const int lo = args.ph_lo, hi = args.ph_hi;
#define IN(k) (lo <= (k) && (k) < hi)
#define BOTH(k) (IN(k) && IN((k) + 1))
    const In& in = args.in;
    bf16* XN = (bf16*)(ws + WS_XN);

    if (IN(0)) { p0_prologue(F, in, ws); if (BOTH(0)) GRID_BAR(); }
    if (IN(1)) {
        pg8::Gemm g{XN, (const bf16*)(ws + WS_WIN), M, N1, DM}; pg8::StaticOrder S; S.init(M, N1, F.G, (int)blockIdx.x);
        EpiInProj E{(bf16*)(ws + WS_QN), (bf16*)(ws + WS_KV), (bf16*)(ws + WS_SB), (bf16*)(ws + WS_GM), (float*)(ws + WS_GN)};
        pg8::gemm_phase<EpiInProj, pg8::StaticOrder, true, true>(F.lds + RING_OFF, g, S, E);
        if (BOTH(1)) GRID_BAR();
    }
    if (IN(2)) {
        for (int i = F.vcu; i < 256; i += F.G) { const int kv = i >> 7, b = (i >> 3) & 15, g = (i >> 2) & 1, cc = i & 3;
            att::cmp_unit(F, ws, kv ? in.p[8] : in.p[4], kv ? in.p[10] : in.p[6], kv, b, g, cc); }
        if (BOTH(2)) GRID_BAR();
    }
    if (IN(3)) {
        for (int i = F.vcu; i < 1024; i += F.G) { const int v = i & 255, k = i >> 8, bg = v >> 3, s = v & 7;
            const int j = (k == 0) ? s : (k == 1) ? 15 - s : (k == 2) ? 16 + s : 31 - s;
            att::nsa_unit(F, ws, in.p[3], bg >> 1, bg & 1, j); }
        for (int i = F.vcu; i < 1024; i += F.G) { const int v = i & 255, k = i >> 8, bh = v >> 1, s = v & 1;
            const int qb = (k == 0) ? s : (k == 1) ? 3 - s : (k == 2) ? 4 + s : 7 - s;
            att::sb_unit(F, ws, bh >> 3, bh & 7, qb); }
        __syncthreads();
        if (BOTH(3)) GRID_BAR();
    }
    if (IN(4)) {
        { pg8::Gemm g{(const bf16*)(ws + WS_ONSA), (const bf16*)(ws + WS_WN), M, DM, 512}; pg8::StaticOrder S; S.init(M, DM, F.G, (int)blockIdx.x);
          EpiUp<false> E{(bf16*)(ws + WS_MIX), (const bf16*)(ws + WS_GM)};
          pg8::gemm_phase<EpiUp<false>, pg8::StaticOrder, true, true>(F.lds + RING_OFF, g, S, E); }
        asm volatile("s_waitcnt vmcnt(0)" ::: "memory"); __syncthreads();
        { pg8::Gemm g{(const bf16*)(ws + WS_OSB), (const bf16*)(ws + WS_WSB), M, DM, 512}; pg8::StaticOrder S; S.init(M, DM, F.G, (int)blockIdx.x);
          EpiUp<true> E{(bf16*)(ws + WS_MIX), (const bf16*)(ws + WS_GM) + 1024};
          pg8::gemm_phase<EpiUp<true>, pg8::StaticOrder, true, true>(F.lds + RING_OFF, g, S, E); }
        if (BOTH(4)) GRID_BAR();
    }
    if (IN(5)) {
        pg8::Gemm g{(const bf16*)(ws + WS_MIX), (const bf16*)(ws + WS_WO), M, DM, DM}; pg8::StaticOrder S; S.init(M, DM, F.G, (int)blockIdx.x);
        EpiOut E{in.p[0], args.out, (bf16*)(ws + WS_X1B), (float*)(ws + WS_ROWSS)};
        pg8::gemm_phase<EpiOut, pg8::StaticOrder, true, true>(F.lds + RING_OFF, g, S, E);
        if (BOTH(5)) GRID_BAR();
    }
    if (IN(6)) {
        pg8::Gemm g{(const bf16*)(ws + WS_X1B), (const bf16*)(ws + WS_W1), M, FF, DM}; pg8::StaticOrder S; S.init(M, FF, F.G, (int)blockIdx.x);
        EpiFF1 E{(bf16*)(ws + WS_F), (const float*)(ws + WS_ROWSS)};
        pg8::gemm_phase<EpiFF1, pg8::StaticOrder, true, true>(F.lds + RING_OFF, g, S, E);
        if (BOTH(6)) GRID_BAR();
    }
    if (IN(7)) {
        pg8::Gemm g{(const bf16*)(ws + WS_F), (const bf16*)(ws + WS_W2), M, DM, FF}; pg8::StaticOrder S; S.init(M, DM, F.G, (int)blockIdx.x);
        EpiFF2 E{args.out};
        pg8::gemm_phase<EpiFF2, pg8::StaticOrder, true, true>(F.lds + RING_OFF, g, S, E);
        if (BOTH(7)) GRID_BAR();
    }
    if (IN(8)) {
        const int gw = F.vcu * NWAVES + F.wave, NGW = F.G * NWAVES;
        for (int m = gw; m < M; m += NGW) final_norm_row(F.lane, args.out + (size_t)m * DM, in.p[18]);
    }
#undef IN
#undef BOTH
}

extern "C" void kernel_launch(void* const* d_in, const int* in_sizes, int n_in, void* d_out, int out_size, void* d_ws, size_t ws_size, hipStream_t stream) {
    static int grid = 0;
    if (grid == 0) {
        if (n_in != 19 || in_sizes[0] != M * DM || out_size != M * DM || ws_size < WS_END) { fprintf(stderr, "kernel_launch: unexpected shapes (n_in %d, in0 %d, out %d, ws %zu); nothing launched\n", n_in, n_in > 0 ? in_sizes[0] : -1, out_size, ws_size); grid = -1; return; }
        int dev = 0, cus = 0, per_cu = 0;
        if (hipGetDevice(&dev) != hipSuccess || hipDeviceGetAttribute(&cus, hipDeviceAttributeMultiprocessorCount, dev) != hipSuccess) { grid = -1; return; }
        if (hipFuncSetAttribute((const void*)fwd_kernel, hipFuncAttributeMaxDynamicSharedMemorySize, LDS_BYTES) != hipSuccess) { fprintf(stderr, "kernel_launch: hipFuncSetAttribute failed\n"); grid = -1; return; }
        if (hipOccupancyMaxActiveBlocksPerMultiprocessor(&per_cu, (const void*)fwd_kernel, NWAVES * 64, LDS_BYTES) != hipSuccess || per_cu < 1) { fprintf(stderr, "kernel_launch: occupancy query reports %d blocks per CU\n", per_cu); per_cu = 1; }
        (void)hipGetLastError();
        grid = cus;
    }
    if (grid < 0) return;
    (void)hipMemsetAsync((char*)d_ws + WS_CTL, 0, CTL_ZERO_BYTES, stream);
    Args a{};
    for (int i = 0; i < 19; ++i) a.in.p[i] = (const float*)d_in[i];
    a.out = (float*)d_out; a.ws = (unsigned char*)d_ws;
    if (MK_N_LAUNCHES == 1) {
        a.ph_lo = 0; a.ph_hi = N_PHASES; a.li = 0;
        hipLaunchKernelGGL(fwd_kernel, dim3(grid), dim3(NWAVES * 64), LDS_BYTES, stream, a);
    } else {
        for (int li = 0; li < 9; ++li) { a.ph_lo = li; a.ph_hi = li + 1; a.li = li;
            hipLaunchKernelGGL(fwd_kernel, dim3(grid), dim3(NWAVES * 64), LDS_BYTES, stream, a); }
    }
}
```

```cpp
#include <hip/hip_runtime.h>
#include <cstdio>
#include <cstdint>
namespace pg8 {
#define PG8_LAS __attribute__((address_space(3)))
typedef unsigned short bf16_t;
typedef short bf16x8 __attribute__((ext_vector_type(8)));
typedef float f32x4 __attribute__((ext_vector_type(4)));
typedef unsigned u32x4 __attribute__((ext_vector_type(4)));
constexpr int BM = 256, BK = 64, HALF = 128, HTB = HALF * BK * 2  , STAGE_BYTES = 8 * HTB, NXCD = 8, WGM = 8;

__host__ __device__ __forceinline__ int lds_byte(int r, int c) { const int st = (r >> 4) * 2 + (c >> 5), rr = r & 15, cc = c & 31, ob = rr * 64 + cc * 2; return st * 1024 + (ob ^ (((ob >> 9) & 1) << 5)); }
__host__ __device__ __forceinline__ void stage_rc(int b, int& R, int& C) { const int st = b / 1024, sb = b % 1024, swz = sb ^ (((sb >> 9) & 1) << 5); R = (st >> 1) * 16 + swz / 64; C = (st & 1) * 32 + (swz % 64) / 2; }
__host__ __device__ __forceinline__ int perm32(int rho) { const int n = rho >> 4, i = rho & 15; return 8 * (i >> 2) + 4 * n + (i & 3); }

struct Unit { int pm, pn; };
struct Gemm { const bf16_t* A; const bf16_t* Bt; int M, N, K; };

struct StaticOrder {
    int nM, nN, nwg, G, c;
    __host__ __device__ void init(int M, int N, int G_, int c_) { nM = M / BM; nN = N / BM; nwg = nM * nN; G = G_; c = c_; }
    __host__ __device__ bool next(int i, Unit& u) const {
        const long L = (long)i * G + c; if (L >= nwg) return false;
        int wgid = (int)L; { const int q = nwg / NXCD, r = nwg % NXCD, xcd = wgid % NXCD, off = wgid / NXCD; wgid = (xcd < r ? xcd * (q + 1) : r * (q + 1) + (xcd - r) * q) + off; }
        const int nig = WGM * nN, gid = wgid / nig, fm = gid * WGM, gsz = (nM - fm) < WGM ? (nM - fm) : WGM;
        u.pm = fm + ((wgid % nig) % gsz); u.pn = (wgid % nig) / gsz; return true;
    }
    __device__ __forceinline__ void a_ready(const Unit&) const {}
    __device__ __forceinline__ void done(const Unit&) const {}
};

__device__ __forceinline__ unsigned cvt_pk_bf16(float lo, float hi) { unsigned r; asm volatile("v_cvt_pk_bf16_f32 %0, %1, %2" : "=v"(r) : "v"(lo), "v"(hi)); return r; }
typedef float f32x2 __attribute__((ext_vector_type(2)));
template <class Epi, class Sched, bool ALIGN_EPI = false, bool SP2 = false>
__device__ __forceinline__ void gemm_phase(PG8_LAS unsigned char* lds, const Gemm g, const Sched& S, const Epi& E) {
    const int tid = threadIdx.x, wid = __builtin_amdgcn_readfirstlane(tid >> 6), lane = tid & 63, wr = wid >> 2, wc = wid & 3, fr = lane & 15, fq = lane >> 4;
    const int K = g.K, nt = K / BK;
    unsigned voffA[2], voffB[2];
#pragma unroll
    for (int i = 0; i < 2; ++i) { int R, C; stage_rc(tid * 16 + i * 8192, R, C); const int Rb = Epi::PERM ? ((R & ~31) + perm32(R & 31)) : R;
        voffA[i] = (unsigned)(R * K + C) * 2u; voffB[i] = (unsigned)(Rb * K + C) * 2u; }
    const size_t kstep = (size_t)(BK * 2);
    const size_t hstep = (size_t)HALF * K * 2;
    const size_t tstep = 2 * hstep;
    const unsigned ldsw = (unsigned)wid * 1024u;
    const int aoff = lds_byte(wr * 64 + fr, fq * 8), boff = lds_byte(wc * 32 + fr, fq * 8);
#define PG8_SA(b, h) (((b) * 2 + (h)) * HTB)
#define PG8_SB(b, h) ((4 + (b) * 2 + (h)) * HTB)
#define PG8_STAGE(bufoff, gbase, voff) do { _Pragma("unroll") for (int _i = 0; _i < 2; ++_i) \
        __builtin_amdgcn_global_load_lds((const unsigned*)((const char*)(gbase) + (voff)[_i]), (PG8_LAS unsigned*)(lds + (bufoff) + ldsw + _i * 8192), 16, 0, 0); } while (0)
#define PG8_LDA(dst, b, h) do { _Pragma("unroll") for (int m = 0; m < 4; ++m) _Pragma("unroll") for (int k = 0; k < 2; ++k) dst[m][k] = *(const PG8_LAS bf16x8*)(lds + PG8_SA(b, h) + aoff + m * 2048 + k * 1024); } while (0)
#define PG8_LDB(dst, b, h) do { _Pragma("unroll") for (int n = 0; n < 2; ++n) _Pragma("unroll") for (int k = 0; k < 2; ++k) dst[n][k] = *(const PG8_LAS bf16x8*)(lds + PG8_SB(b, h) + boff + n * 2048 + k * 1024); } while (0)
#define PG8_MMA(ai, bj, At, Bt) do { __builtin_amdgcn_s_setprio(1); _Pragma("unroll") for (int m = 0; m < 4; ++m) _Pragma("unroll") for (int n = 0; n < 2; ++n) _Pragma("unroll") for (int k = 0; k < 2; ++k) \
        acc[ai][bj][m][n] = __builtin_amdgcn_mfma_f32_16x16x32_bf16(Bt[n][k], At[m][k], acc[ai][bj][m][n], 0, 0, 0); __builtin_amdgcn_s_setprio(0); } while (0)
#define PG8_WAIT_V(n) asm volatile("s_waitcnt vmcnt(" #n ")" ::: "memory")
#define PG8_WAIT_L(n) asm volatile("s_waitcnt lgkmcnt(" #n ")" ::: "memory")
#define PG8_BAR __builtin_amdgcn_s_barrier()
#define PG8_SCHED __builtin_amdgcn_sched_barrier(0)
    Unit cur, nxt; int ui = 0;
    if (!S.next(0, cur)) return;
    f32x4 acc[2][2][4][2];
#pragma unroll
    for (int a = 0; a < 2; ++a)
#pragma unroll
        for (int b = 0; b < 2; ++b)
#pragma unroll
            for (int m = 0; m < 4; ++m)
#pragma unroll
                for (int n = 0; n < 2; ++n) acc[a][b][m][n] = (f32x4){0.f, 0.f, 0.f, 0.f};
    bf16x8 At[4][2], B0[2][2], B1[2][2];
    const char* cA = (const char*)g.A + (size_t)cur.pm * tstep; const char* cB = (const char*)g.Bt + (size_t)cur.pn * tstep;
    S.a_ready(cur);
    if constexpr (SP2) {
        PG8_STAGE(PG8_SB(0, 0), cB, voffB); PG8_STAGE(PG8_SB(0, 1), cB + hstep, voffB); PG8_STAGE(PG8_SA(0, 0), cA, voffA); PG8_STAGE(PG8_SA(0, 1), cA + hstep, voffA);
        if (wr == 1) PG8_BAR;
        PG8_WAIT_V(2); PG8_BAR;
        PG8_STAGE(PG8_SB(1, 0), cB + kstep, voffB); PG8_STAGE(PG8_SA(1, 0), cA + kstep, voffA); PG8_STAGE(PG8_SB(1, 1), cB + hstep + kstep, voffB);
        PG8_WAIT_V(6); PG8_BAR;
    } else {
        PG8_STAGE(PG8_SB(0, 0), cB, voffB); PG8_STAGE(PG8_SA(0, 0), cA, voffA); PG8_STAGE(PG8_SB(0, 1), cB + hstep, voffB); PG8_STAGE(PG8_SA(0, 1), cA + hstep, voffA);
        if (wr == 1) PG8_BAR;
        PG8_WAIT_V(4); PG8_BAR;
        PG8_STAGE(PG8_SB(1, 0), cB + kstep, voffB); PG8_STAGE(PG8_SA(1, 0), cA + kstep, voffA); PG8_STAGE(PG8_SB(1, 1), cB + hstep + kstep, voffB);
        PG8_WAIT_V(6); PG8_BAR;
    }
    for (;;) {
        const bool has_next = S.next(ui + 1, nxt);
        const char* nA = has_next ? (const char*)g.A + (size_t)nxt.pm * tstep : cA; const char* nB = has_next ? (const char*)g.Bt + (size_t)nxt.pn * tstep : cB;
        for (int t = 0; t < nt; t += 2) {
            const bool last = (t == nt - 2);
            const char* a1 = cA + (size_t)(t + 1) * kstep;
            const char* a2 = last ? nA : cA + (size_t)(t + 2) * kstep; const char* b2 = last ? nB : cB + (size_t)(t + 2) * kstep;
            const char* a3 = a2 + kstep; const char* b3 = b2 + kstep;
            if (last && has_next) S.a_ready(nxt);
            if constexpr (SP2) {
            PG8_LDB(B0, 0, 0); PG8_LDB(B1, 0, 1); PG8_SCHED; PG8_LDA(At, 0, 0); PG8_STAGE(PG8_SA(1, 1), a1 + hstep, voffA);
            PG8_WAIT_V(8); PG8_WAIT_L(0); PG8_BAR; PG8_MMA(0, 0, At, B0); PG8_MMA(0, 1, At, B1); PG8_BAR; PG8_SCHED;
            PG8_LDA(At, 0, 1); PG8_STAGE(PG8_SB(0, 0), b2, voffB); PG8_STAGE(PG8_SB(0, 1), b2 + hstep, voffB); PG8_STAGE(PG8_SA(0, 0), a2, voffA);
            PG8_WAIT_V(8); PG8_WAIT_L(0); PG8_BAR; PG8_MMA(1, 0, At, B0); PG8_MMA(1, 1, At, B1); PG8_BAR; PG8_SCHED;
            PG8_LDB(B0, 1, 0); PG8_LDB(B1, 1, 1); PG8_SCHED; PG8_LDA(At, 1, 0); PG8_STAGE(PG8_SA(0, 1), a2 + hstep, voffA);
            PG8_WAIT_V(8); PG8_WAIT_L(0); PG8_BAR; PG8_MMA(0, 0, At, B0); PG8_MMA(0, 1, At, B1); PG8_BAR; PG8_SCHED;
            PG8_LDA(At, 1, 1); PG8_STAGE(PG8_SB(1, 0), b3, voffB); PG8_STAGE(PG8_SB(1, 1), b3 + hstep, voffB); PG8_STAGE(PG8_SA(1, 0), a3, voffA);
            PG8_WAIT_V(8); PG8_WAIT_L(0); PG8_BAR; PG8_MMA(1, 0, At, B0); PG8_MMA(1, 1, At, B1); PG8_BAR; PG8_SCHED;
            } else {
            PG8_LDB(B0, 0, 0); PG8_SCHED; PG8_LDA(At, 0, 0); PG8_STAGE(PG8_SA(1, 1), a1 + hstep, voffA);
            PG8_WAIT_L(8); PG8_BAR; PG8_WAIT_L(0); PG8_MMA(0, 0, At, B0); PG8_BAR; PG8_SCHED;
            PG8_LDB(B1, 0, 1); PG8_STAGE(PG8_SB(0, 0), b2, voffB);
            PG8_BAR; PG8_WAIT_L(0); PG8_MMA(0, 1, At, B1); PG8_BAR;
            PG8_LDA(At, 0, 1); PG8_STAGE(PG8_SA(0, 0), a2, voffA);
            PG8_BAR; PG8_WAIT_L(0); PG8_MMA(1, 0, At, B0); PG8_BAR; PG8_SCHED;
            PG8_STAGE(PG8_SB(0, 1), b2 + hstep, voffB);
            PG8_WAIT_V(6); PG8_BAR; PG8_MMA(1, 1, At, B1); PG8_BAR;
            PG8_LDB(B0, 1, 0); PG8_SCHED; PG8_LDA(At, 1, 0); PG8_STAGE(PG8_SA(0, 1), a2 + hstep, voffA);
            PG8_WAIT_L(8); PG8_BAR; PG8_WAIT_L(0); PG8_MMA(0, 0, At, B0); PG8_BAR; PG8_SCHED;
            PG8_LDB(B1, 1, 1); PG8_STAGE(PG8_SB(1, 0), b3, voffB);
            PG8_BAR; PG8_WAIT_L(0); PG8_MMA(0, 1, At, B1); PG8_BAR;
            PG8_LDA(At, 1, 1); PG8_STAGE(PG8_SA(1, 0), a3, voffA);
            PG8_BAR; PG8_WAIT_L(0); PG8_MMA(1, 0, At, B0); PG8_BAR; PG8_SCHED;
            PG8_STAGE(PG8_SB(1, 1), b3 + hstep, voffB);
            PG8_WAIT_V(6); PG8_BAR; PG8_MMA(1, 1, At, B1); PG8_BAR;
            }
        }
        if constexpr (ALIGN_EPI) { if (wr == 0) PG8_BAR; }
        if constexpr (!Epi::AFTER_DRAIN) { E(acc, cur, wr, wc, fr, fq); S.done(cur); }
        if (!has_next) break;
#pragma unroll
        for (int a = 0; a < 2; ++a)
#pragma unroll
            for (int b = 0; b < 2; ++b)
#pragma unroll
                for (int m = 0; m < 4; ++m)
#pragma unroll
                    for (int n = 0; n < 2; ++n) acc[a][b][m][n] = (f32x4){0.f, 0.f, 0.f, 0.f};
        cur = nxt; cA = nA; cB = nB; ++ui;
        if constexpr (ALIGN_EPI) { if (wr == 1) PG8_BAR; }
    }
    PG8_WAIT_V(0);
    if constexpr (!ALIGN_EPI) { if (wr == 0) PG8_BAR; }
    PG8_BAR;
    if constexpr (Epi::AFTER_DRAIN) { E.fused(acc, cur, wr, wc, fr, fq, lds, wid, lane); S.done(cur); }
#undef PG8_SA
#undef PG8_SB
#undef PG8_STAGE
#undef PG8_LDA
#undef PG8_LDB
#undef PG8_MMA
#undef PG8_WAIT_V
#undef PG8_WAIT_L
#undef PG8_BAR
#undef PG8_SCHED
}
}
#define GAS __attribute__((address_space(1)))
#define LAS __attribute__((address_space(3)))
typedef unsigned short bf16;
typedef unsigned v4u __attribute__((ext_vector_type(4)));
typedef float f32x4 __attribute__((ext_vector_type(4)));
typedef short bf16x8 __attribute__((ext_vector_type(8)));
typedef GAS unsigned gu32;
typedef GAS unsigned long long gu64;
#define RLX_AGENT __ATOMIC_RELAXED, __HIP_MEMORY_SCOPE_AGENT
#define LDS_WAIT() asm volatile("s_waitcnt lgkmcnt(0)" ::: "memory")
#define VM_WAIT() asm volatile("s_waitcnt vmcnt(0)" ::: "memory")
__device__ __forceinline__ unsigned long long rt() { return __builtin_amdgcn_s_memrealtime(); }
__device__ __forceinline__ unsigned f2bf(float f) { unsigned u = __builtin_bit_cast(unsigned, f); return (u + 0x7fffu + ((u >> 16) & 1u)) >> 16; }
__device__ __forceinline__ unsigned pk2(float lo, float hi) { return f2bf(lo) | (f2bf(hi) << 16); }

#define XB_TMO      128
#define XB_XCNT(j)  (256  + 64 * (j))
#define XB_XSUB(j)  (1280 + 64 * (j))
#define XB_XGEN(j)  (2304 + 64 * (j))
#define XB_TOP      3328
#define XB_TOPGEN   3392
#define XCD_BAR_WORDS 3456
#define XB_SPIN_CAP (1u << 18)

__device__ __forceinline__ unsigned xb_ld(unsigned* p)              { return __hip_atomic_load(p, __ATOMIC_RELAXED, __HIP_MEMORY_SCOPE_AGENT); }
__device__ __forceinline__ unsigned xb_add(unsigned* p, unsigned v) { return __hip_atomic_fetch_add(p, v, __ATOMIC_RELAXED, __HIP_MEMORY_SCOPE_AGENT); }
__device__ __forceinline__ unsigned xb_xcc_id() { return (unsigned)__builtin_amdgcn_s_getreg((3 << 11) | 20) & 0xFu; }
#define XB_SPIN(cond, bar) do { unsigned _sp = 0; while (cond) { __builtin_amdgcn_s_sleep(1); \
    if ((++_sp & 255u) == 0u) { if (xb_ld(&(bar)[XB_TMO])) break; if (_sp > XB_SPIN_CAP) { atomicAdd(&(bar)[XB_TMO], 1u); break; } } } } while (0)

struct XcdBarrier {
    unsigned* bar; unsigned x;
    volatile LAS unsigned* st;
};

__device__ __forceinline__ XcdBarrier xcd_barrier_post(unsigned* bar, volatile LAS unsigned* st) {
    XcdBarrier b; b.bar = bar; b.x = xb_xcc_id(); b.st = st;
    if (threadIdx.x == 0) (void)xb_add(&bar[XB_XCNT(b.x)], 1u);
    return b;
}
__device__ __forceinline__ void xcd_barrier_complete(unsigned* bar, unsigned x, unsigned& nloc, unsigned& nx) {
    const unsigned G = gridDim.x * gridDim.y * gridDim.z;
    unsigned sum, cnt, mine, sp = 0u;
    for (;;) {
        sum = 0u; cnt = 0u; mine = 0u;
#pragma unroll
        for (unsigned j = 0; j < 16; ++j) { const unsigned c = xb_ld(&bar[XB_XCNT(j)]); sum += c; cnt += (c > 0u) ? 1u : 0u; mine = (j == x) ? c : mine; }
        if (sum == G) break;
        __builtin_amdgcn_s_sleep(1);
        if ((++sp & 255u) == 0u) { if (xb_ld(&bar[XB_TMO])) break; if (sp > XB_SPIN_CAP) { atomicAdd(&bar[XB_TMO], 1u); break; } }
    }
    nloc = mine > 0u ? mine : 1u; nx = cnt > 0u ? cnt : 1u;
}

__device__ __forceinline__ void xcd_barrier(const XcdBarrier& b) {
    asm volatile("s_waitcnt vmcnt(0)" ::: "memory");
    __syncthreads();
    if (threadIdx.x == 0) {
        unsigned* bar = b.bar;
        __builtin_amdgcn_s_waitcnt(0);
        unsigned nloc = b.st[0], nx = b.st[1];
        if (nloc == 0u) { xcd_barrier_complete(bar, b.x, nloc, nx); b.st[0] = nloc; b.st[1] = nx; }
        const unsigned old = xb_add(&bar[XB_XSUB(b.x)], 1u);
        const unsigned gen = old / nloc;
        if (old + 1u == (gen + 1u) * nloc) {
            __builtin_amdgcn_fence(__ATOMIC_RELEASE, "agent");
            asm volatile("s_waitcnt vmcnt(0)" ::: "memory");
            const unsigned og = xb_add(&bar[XB_TOP], 1u);
            const unsigned tg = og / nx;
            if (og + 1u == (tg + 1u) * nx) xb_add(&bar[XB_TOPGEN], 1u);
            else XB_SPIN(xb_ld(&bar[XB_TOPGEN]) == tg, bar);
            __builtin_amdgcn_fence(__ATOMIC_ACQUIRE, "agent");
            xb_add(&bar[XB_XGEN(b.x)], 1u);
            asm volatile("s_waitcnt vmcnt(0)" ::: "memory");
        } else {
            XB_SPIN(xb_ld(&bar[XB_XGEN(b.x)]) == gen, bar);
            __builtin_amdgcn_fence(__ATOMIC_ACQUIRE, "agent");
            asm volatile("s_waitcnt vmcnt(0)" ::: "memory");
        }
    }
    __syncthreads();
}

typedef float f32x16 __attribute__((ext_vector_type(16)));
typedef short s16x4 __attribute__((ext_vector_type(4)));
typedef unsigned v2u __attribute__((ext_vector_type(2)));

constexpr int NWAVES = 8;
constexpr int BATCH = 16, SEQ = 2048, DM = 1024, M = BATCH * SEQ;
constexpr int FF = 4096;
constexpr int IN_COLS = 4888, N1 = 5120;
constexpr float EPS = 1e-6f;
constexpr float LOG2E = 1.4426950408889634f;
constexpr float QSCALE = 0.125f * LOG2E;
constexpr float NEGBIG = -1e30f;

__constant__ unsigned char T5B[129] = {0,1,2,3,4,5,6,7,8,9,10,11,12,13,14,15,16,16,16,17,17,18,18,18,19,19,19,20,20,20,20,21,21,21,21,22,22,22,22,22,23,23,23,23,23,23,24,24,24,24,24,24,25,25,25,25,25,25,25,26,26,26,26,26,26,26,26,27,27,27,27,27,27,27,27,27,27,28,28,28,28,28,28,28,28,28,28,29,29,29,29,29,29,29,29,29,29,29,29,30,30,30,30,30,30,30,30,30,30,30,30,30,30,31,31,31,31,31,31,31,31,31,31,31,31,31,31,31,31};

constexpr size_t MiB = 1u << 20;
constexpr size_t WS_CTL = 0, CTL_ZERO_BYTES = 1 * MiB;
constexpr size_t WS_ROWSS = 512 * 1024;
constexpr size_t WS_B1P = 768 * 1024;
constexpr size_t WS_WIN = 2 * MiB, WS_WN = 12 * MiB, WS_WSB = 13 * MiB, WS_WO = 14 * MiB, WS_W1 = 16 * MiB, WS_W2 = 24 * MiB;
constexpr size_t WS_CW1K = 32 * MiB, WS_CW1V = 33 * MiB, WS_CW2K = 34 * MiB, WS_CW2V = 34 * MiB + 65536;
constexpr size_t WS_KC = 35 * MiB, WS_VC = 36 * MiB;
constexpr size_t WS_XN = 40 * MiB;
constexpr size_t WS_QN = 104 * MiB;
constexpr size_t WS_KV = 136 * MiB;
constexpr size_t WS_SB = 184 * MiB;
constexpr size_t WS_GN = 280 * MiB;
constexpr size_t WS_GM = 284 * MiB;
constexpr size_t WS_END = 412 * MiB;
constexpr size_t WS_ONSA = 40 * MiB, WS_OSB = 72 * MiB;
constexpr size_t WS_MIX = 184 * MiB;
constexpr size_t WS_F = 40 * MiB;
constexpr size_t WS_X1B = 348 * MiB;
constexpr size_t KVARR = (size_t)BATCH * 2 * SEQ * 64;
constexpr size_t SBARR = (size_t)BATCH * 8 * SEQ * 64;
constexpr int CW_BAR = 4096;

constexpr int RING_OFF = 0, RING_BYTES = 131072;
constexpr int LDSCTL_OFF = RING_BYTES, MISC_OFF = LDSCTL_OFF + 320;
constexpr int LDS_BYTES = 147456;

#ifndef MK_N_LAUNCHES
#define MK_N_LAUNCHES 1
#endif
constexpr int N_PHASES = 10;

struct Frame {
    LAS unsigned char* lds;
    volatile LAS unsigned* MISC;
    gu32* ctl;
    int tid, lane, wave;
    int vcu, G;
};

__device__ __forceinline__ float wave_sum(float v) {
#pragma unroll
    for (int o = 1; o < 64; o <<= 1) v += __shfl_xor(v, o);
    return v;
}
__device__ __forceinline__ float bf2f(unsigned short b) { return __builtin_bit_cast(float, (unsigned)b << 16); }
__device__ __forceinline__ float fast_exp2(float x) { return __builtin_amdgcn_exp2f(x); }
__device__ __forceinline__ float fast_sigmoid(float x) { return __builtin_amdgcn_rcpf(1.0f + fast_exp2(-x * LOG2E)); }
typedef float f32x2_t __attribute__((ext_vector_type(2))); typedef __bf16 bf16x2_t __attribute__((ext_vector_type(2)));
__device__ __forceinline__ unsigned cvtpk(float lo, float hi) { f32x2_t v = {lo, hi}; bf16x2_t b = __builtin_convertvector(v, bf16x2_t); return __builtin_bit_cast(unsigned, b); }

__device__ __forceinline__ void transpose_item(const float* W, int K, int ldn, int n0, const float* kscale, bf16* WT, int drow0, LAS float* scr, int kb, int lane) {
    const int k0 = 64 * kb;
    const int c = lane & 7;
    if (n0 < 0) {
#pragma unroll
        for (int j = 0; j < 4; ++j) { const int n = (lane >> 3) + 8 * j; *(GAS v4u*)(WT + (size_t)(drow0 + n) * K + k0 + 8 * c) = (v4u){0u, 0u, 0u, 0u}; }
        return;
    }
#pragma unroll 8
    for (int i = 0; i < 32; ++i) { const int kk = 2 * i + (lane >> 5); float v = W[(size_t)(k0 + kk) * ldn + n0 + (lane & 31)]; if (kscale) v *= kscale[k0 + kk]; scr[kk * 33 + (lane & 31)] = v; }
    LDS_WAIT(); asm volatile("" ::: "memory");
#pragma unroll
    for (int j = 0; j < 4; ++j) { const int n = (lane >> 3) + 8 * j; const LAS float* s = scr + (8 * c) * 33 + n;
        v4u o; o.x = pk2(s[0 * 33], s[1 * 33]); o.y = pk2(s[2 * 33], s[3 * 33]); o.z = pk2(s[4 * 33], s[5 * 33]); o.w = pk2(s[6 * 33], s[7 * 33]);
        *(GAS v4u*)(WT + (size_t)(drow0 + n) * K + k0 + 8 * c) = o; }
    LDS_WAIT(); asm volatile("" ::: "memory");
}
__device__ __forceinline__ void rms_row_to_bf16(int lane, const float* xrow, const float* g, bf16* orow) {
    const GAS f32x4* xr = (const GAS f32x4*)xrow + lane; const GAS f32x4* gr = (const GAS f32x4*)g + lane;
    f32x4 v[4]; float s = 0.f;
#pragma unroll
    for (int j = 0; j < 4; ++j) { v[j] = xr[64 * j]; s += (v[j].x * v[j].x + v[j].y * v[j].y) + (v[j].z * v[j].z + v[j].w * v[j].w); }
    const float rstd = 1.f / sqrtf(wave_sum(s) * (1.f / DM) + EPS);
    GAS unsigned long long* o8 = (GAS unsigned long long*)orow + lane;
#pragma unroll
    for (int j = 0; j < 4; ++j) { const f32x4 gg = gr[64 * j];
        o8[64 * j] = (unsigned long long)pk2(v[j].x * rstd * gg.x, v[j].y * rstd * gg.y) | ((unsigned long long)pk2(v[j].z * rstd * gg.z, v[j].w * rstd * gg.w) << 32); }
}
struct In { const float* p[19]; };
__device__ __forceinline__ void p0_prologue(Frame& F, const In& in, unsigned char* ws) {
    LAS float* scr = (LAS float*)(F.lds + RING_OFF + F.wave * 16384);
    const int gw = F.vcu * NWAVES + F.wave, NGW = F.G * NWAVES;
    constexpr int I_IN = 16 * 160, I_UP = 8 * 32, I_O = 16 * 32, I_1 = 16 * 128, I_2 = 64 * 32, I_C1 = 32 * 8, I_C2 = 4 * 2;
    constexpr int NITEMS = I_IN + 2 * I_UP + I_O + I_1 + I_2 + 2 * I_C1 + 2 * I_C2;
    for (int it = gw; it < NITEMS; it += NGW) {
        int r = it;
        if (r < I_IN) { const int kb = r / 160, nb = r % 160; const int d0 = nb * 32;
            const int n0 = d0 < 1280 ? d0 : (d0 < 4864 ? d0 + 24 : (d0 == 4864 ? 1280 : -1));
            transpose_item(in.p[2], 1024, IN_COLS, n0, nullptr, (bf16*)(ws + WS_WIN), d0, scr, kb, F.lane); continue; } r -= I_IN;
        if (r < I_UP) { transpose_item(in.p[12], 512, 1024, (r % 32) * 32, nullptr, (bf16*)(ws + WS_WN), (r % 32) * 32, scr, r / 32, F.lane); continue; } r -= I_UP;
        if (r < I_UP) { transpose_item(in.p[13], 512, 1024, (r % 32) * 32, nullptr, (bf16*)(ws + WS_WSB), (r % 32) * 32, scr, r / 32, F.lane); continue; } r -= I_UP;
        if (r < I_O) { transpose_item(in.p[14], 1024, 1024, (r % 32) * 32, nullptr, (bf16*)(ws + WS_WO), (r % 32) * 32, scr, r / 32, F.lane); continue; } r -= I_O;
        if (r < I_1) { transpose_item(in.p[16], 1024, 4096, (r % 128) * 32, in.p[15], (bf16*)(ws + WS_W1), (r % 128) * 32, scr, r / 128, F.lane); continue; } r -= I_1;
        if (r < I_2) { transpose_item(in.p[17], 4096, 1024, (r % 32) * 32, nullptr, (bf16*)(ws + WS_W2), (r % 32) * 32, scr, r / 32, F.lane); continue; } r -= I_2;
        if (r < I_C1) { transpose_item(in.p[5], 2048, 256, (r % 8) * 32, nullptr, (bf16*)(ws + WS_CW1K), (r % 8) * 32, scr, r / 8, F.lane); continue; } r -= I_C1;
        if (r < I_C1) { transpose_item(in.p[9], 2048, 256, (r % 8) * 32, nullptr, (bf16*)(ws + WS_CW1V), (r % 8) * 32, scr, r / 8, F.lane); continue; } r -= I_C1;
        if (r < I_C2) { transpose_item(in.p[7], 256, 64, (r % 2) * 32, nullptr, (bf16*)(ws + WS_CW2K), (r % 2) * 32, scr, r / 2, F.lane); continue; } r -= I_C2;
        transpose_item(in.p[11], 256, 64, (r % 2) * 32, nullptr, (bf16*)(ws + WS_CW2V), (r % 2) * 32, scr, r / 2, F.lane);
    }
    if (gw < 256) {
        const int kvm = gw >> 7, chunk = (gw >> 2) & 31, nq = gw & 3, n = 64 * nq + F.lane;
        const float* pe = in.p[kvm ? 8 : 4]; const float* w1 = in.p[kvm ? 9 : 5];
        float sum = 0.f;
#pragma unroll 16
        for (int kk = 0; kk < 64; ++kk) sum += pe[64 * chunk + kk] * w1[(size_t)(64 * chunk + kk) * 256 + n];
        atomicAdd((float*)(ws + WS_B1P) + kvm * 256 + n, sum);
    }
    bf16* XN = (bf16*)(ws + WS_XN);
    for (int m = gw; m < M; m += NGW) rms_row_to_bf16(F.lane, in.p[0] + (size_t)m * DM, in.p[1], XN + (size_t)m * DM);
}

__device__ __forceinline__ v4u pack8(const f32x4 a, const f32x4 b) { v4u w; w.x = cvtpk(a[0], a[1]); w.y = cvtpk(a[2], a[3]); w.z = cvtpk(b[0], b[1]); w.w = cvtpk(b[2], b[3]); return w; }
__device__ __forceinline__ f32x4 sig4(const f32x4 a) { f32x4 r; r[0] = fast_sigmoid(a[0]); r[1] = fast_sigmoid(a[1]); r[2] = fast_sigmoid(a[2]); r[3] = fast_sigmoid(a[3]); return r; }

struct EpiInProj {
    static constexpr bool PERM = true, AFTER_DRAIN = false;
    bf16 *QN, *KV, *SB, *GM; float* GN;
    __device__ __forceinline__ void operator()(const f32x4 (&acc)[2][2][4][2], const pg8::Unit& u, int wr, int wc, int fr, int fq) const {
        const int row0 = u.pm * 256 + wr * 64 + fr;
#pragma unroll
        for (int bj = 0; bj < 2; ++bj) {
            const int cb = u.pn * 256 + bj * 128;
            const int c = cb + wc * 32 + 8 * fq;
#pragma unroll
            for (int ai = 0; ai < 2; ++ai)
#pragma unroll
                for (int m = 0; m < 4; ++m) {
                    const int row = row0 + ai * 128 + m * 16; const int b = row >> 11, t = row & 2047;
                    f32x4 v0 = acc[ai][bj][m][0], v1 = acc[ai][bj][m][1];
                    if (cb < 512) { v0 = v0 * QSCALE; v1 = v1 * QSCALE; *(GAS v4u*)(QN + (size_t)row * 512 + c) = pack8(v0, v1); }
                    else if (cb < 1280) { const int cc = c - 512, a = cc >> 7, g = (cc >> 6) & 1, d = cc & 63;
                        *(GAS v4u*)(KV + ((((size_t)a * BATCH + b) * 2 + g) * SEQ + t) * 64 + d) = pack8(v0, v1); }
                    else if (cb < 2816) { const int cc = c - 1280, wh = cc >> 9, h = (cc >> 6) & 7, d = cc & 63;
                        if (wh == 0) { v0 = v0 * QSCALE; v1 = v1 * QSCALE; }
                        *(GAS v4u*)(SB + ((((size_t)wh * BATCH + b) * 8 + h) * SEQ + t) * 64 + d) = pack8(v0, v1); }
                    else if (cb < 4864) { *(GAS v4u*)(GM + (size_t)row * 2048 + (c - 2816)) = pack8(sig4(v0), sig4(v1)); }
                    else { const int cc = c - 4864; if (cc < 24) { GAS f32x4* o = (GAS f32x4*)(GN + (size_t)row * 24 + cc); o[0] = sig4(v0); o[1] = sig4(v1); } }
                }
        }
    }
};
template <bool SECOND> struct EpiUp {
    static constexpr bool PERM = true, AFTER_DRAIN = false;
    bf16* MIX; const bf16* GMg;
    __device__ __forceinline__ void operator()(const f32x4 (&acc)[2][2][4][2], const pg8::Unit& u, int wr, int wc, int fr, int fq) const {
        const int row0 = u.pm * 256 + wr * 64 + fr;
#pragma unroll
        for (int ai = 0; ai < 2; ++ai)
#pragma unroll
            for (int m = 0; m < 4; ++m) { const int row = row0 + ai * 128 + m * 16;
#pragma unroll
                for (int bj = 0; bj < 2; ++bj) { const int c = u.pn * 256 + bj * 128 + wc * 32 + 8 * fq;
                    const v4u gw = *(const GAS v4u*)(GMg + (size_t)row * 2048 + c);
                    float r[8];
#pragma unroll
                    for (int q = 0; q < 4; ++q) { r[2 * q] = __builtin_bit_cast(float, gw[q] << 16); r[2 * q + 1] = __builtin_bit_cast(float, gw[q] & 0xffff0000u); }
                    f32x4 v0 = acc[ai][bj][m][0], v1 = acc[ai][bj][m][1];
#pragma unroll
                    for (int q = 0; q < 4; ++q) { v0[q] *= r[q]; v1[q] *= r[4 + q]; }
                    GAS v4u* dst = (GAS v4u*)(MIX + (size_t)row * 1024 + c);
                    if (SECOND) { const v4u pw = *dst;
#pragma unroll
                        for (int q = 0; q < 2; ++q) { v0[2 * q] += __builtin_bit_cast(float, pw[q] << 16); v0[2 * q + 1] += __builtin_bit_cast(float, pw[q] & 0xffff0000u);
                                                      v1[2 * q] += __builtin_bit_cast(float, pw[2 + q] << 16); v1[2 * q + 1] += __builtin_bit_cast(float, pw[2 + q] & 0xffff0000u); } }
                    *dst = pack8(v0, v1); } }
    }
};
struct EpiOut {
    static constexpr bool PERM = true, AFTER_DRAIN = false;
    const float* X; float* X1; bf16* X1B; float* rowss;
    __device__ __forceinline__ void operator()(const f32x4 (&acc)[2][2][4][2], const pg8::Unit& u, int wr, int wc, int fr, int fq) const {
        const int row0 = u.pm * 256 + wr * 64 + fr;
#pragma unroll
        for (int ai = 0; ai < 2; ++ai)
#pragma unroll
            for (int m = 0; m < 4; ++m) { const int row = row0 + ai * 128 + m * 16; float ss = 0.f;
#pragma unroll
                for (int bj = 0; bj < 2; ++bj) { const int c = u.pn * 256 + bj * 128 + wc * 32 + 8 * fq; const size_t off = (size_t)row * 1024 + c;
                    const f32x4 x0 = *(const GAS f32x4*)(X + off), x1 = *(const GAS f32x4*)(X + off + 4);
                    const f32x4 y0 = x0 + acc[ai][bj][m][0], y1 = x1 + acc[ai][bj][m][1];
                    *(GAS f32x4*)(X1 + off) = y0; *(GAS f32x4*)(X1 + off + 4) = y1; *(GAS v4u*)(X1B + off) = pack8(y0, y1);
                    ss += (y0[0] * y0[0] + y0[1] * y0[1]) + (y0[2] * y0[2] + y0[3] * y0[3]) + (y1[0] * y1[0] + y1[1] * y1[1]) + (y1[2] * y1[2] + y1[3] * y1[3]); }
                ss += __shfl_xor(ss, 16); ss += __shfl_xor(ss, 32);
                if (fq == 0) atomicAdd(rowss + row, ss); }
    }
};
struct EpiFF1 {
    static constexpr bool PERM = true, AFTER_DRAIN = false;
    bf16* Fo; const float* rowss;
    __device__ __forceinline__ void operator()(const f32x4 (&acc)[2][2][4][2], const pg8::Unit& u, int wr, int wc, int fr, int fq) const {
        const int row0 = u.pm * 256 + wr * 64 + fr;
#pragma unroll
        for (int ai = 0; ai < 2; ++ai)
#pragma unroll
            for (int m = 0; m < 4; ++m) { const int row = row0 + ai * 128 + m * 16;
                const float rs2 = 1.0f / (rowss[row] * (1.0f / DM) + EPS);
#pragma unroll
                for (int bj = 0; bj < 2; ++bj) { const int c = u.pn * 256 + bj * 128 + wc * 32 + 8 * fq;
                    f32x4 v0 = acc[ai][bj][m][0], v1 = acc[ai][bj][m][1];
#pragma unroll
                    for (int q = 0; q < 4; ++q) { const float a = fmaxf(v0[q], 0.f), b = fmaxf(v1[q], 0.f); v0[q] = a * a * rs2; v1[q] = b * b * rs2; }
                    *(GAS v4u*)(Fo + (size_t)row * FF + c) = pack8(v0, v1); } }
    }
};
struct EpiFF2 {
    static constexpr bool PERM = true, AFTER_DRAIN = false;
    float* X1;
    __device__ __forceinline__ void operator()(const f32x4 (&acc)[2][2][4][2], const pg8::Unit& u, int wr, int wc, int fr, int fq) const {
        const int row0 = u.pm * 256 + wr * 64 + fr;
#pragma unroll
        for (int ai = 0; ai < 2; ++ai)
#pragma unroll
            for (int m = 0; m < 4; ++m) { const int row = row0 + ai * 128 + m * 16;
#pragma unroll
                for (int bj = 0; bj < 2; ++bj) { const int c = u.pn * 256 + bj * 128 + wc * 32 + 8 * fq; GAS f32x4* p = (GAS f32x4*)(X1 + (size_t)row * 1024 + c);
                    p[0] = p[0] + acc[ai][bj][m][0]; p[1] = p[1] + acc[ai][bj][m][1]; } }
    }
};

namespace att {
typedef short v4i16_t __attribute__((ext_vector_type(4)));
constexpr int L_K0 = 0, L_K1 = 8192, L_V0 = 16384, L_V1 = 24576, L_BIAS = 32768, L_WMASK = 36864, L_DONE = 36928;
constexpr int L_CA = 0, L_HID = 69632;
__device__ __forceinline__ int crow(int r, int hi) { return (r & 3) + 8 * (r >> 2) + 4 * hi; }
__device__ __forceinline__ s16x4 vtr(const LAS unsigned char* p) { return __builtin_bit_cast(s16x4, __builtin_amdgcn_ds_read_tr16_b64_v4i16((LAS v4i16_t*)p)); }
__device__ __forceinline__ float swapmax(float v) { auto rr = __builtin_amdgcn_permlane32_swap(__float_as_uint(v), __float_as_uint(v), false, false); return fmaxf(__uint_as_float(rr[0]), __uint_as_float(rr[1])); }
__device__ __forceinline__ float swapsum(float v) { auto rr = __builtin_amdgcn_permlane32_swap(__float_as_uint(v), __float_as_uint(v), false, false); return __uint_as_float(rr[0]) + __uint_as_float(rr[1]); }

__device__ __forceinline__ v4u ld_piece(const bf16* g, int tid) { return *(const GAS v4u*)((const GAS char*)g + tid * 16); }
__device__ __forceinline__ void st_kimg(LAS unsigned char* K, int tid, v4u v) { const int key = tid >> 3, ch = tid & 7; *(LAS v4u*)(K + ch * 1024 + key * 16) = v; }
__device__ __forceinline__ void st_vimg(LAS unsigned char* V, int tid, v4u v) { const int key = tid >> 3, c8 = tid & 7; *(LAS v4u*)(V + ((c8 >> 2) * 4 + (key >> 4)) * 1024 + (key & 15) * 64 + (c8 & 3) * 16) = v; }

__device__ __forceinline__ void qkt(f32x16& p0, f32x16& p1, const LAS unsigned char* Kimg, const bf16x8 (&qr)[4], int r32, int hi) {
    const LAS unsigned char* kb = Kimg + hi * 1024 + r32 * 16;
    f32x16 a = {}, b = {};
#pragma unroll
    for (int d0 = 0; d0 < 4; ++d0) {
        const bf16x8 k0 = *(const LAS bf16x8*)(kb + d0 * 2048);
        const bf16x8 k1 = *(const LAS bf16x8*)(kb + d0 * 2048 + 512);
        a = __builtin_amdgcn_mfma_f32_32x32x16_bf16(k0, qr[d0], a, 0, 0, 0);
        b = __builtin_amdgcn_mfma_f32_32x32x16_bf16(k1, qr[d0], b, 0, 0, 0);
    }
    p0 = a; p1 = b;
}
__device__ __forceinline__ void pv(f32x16 (&o)[2], const LAS unsigned char* Vimg, int lane, const f32x16& p0, const f32x16& p1) {
    const int hi = lane >> 5;
    const LAS unsigned char* vb = Vimg + ((lane >> 4) & 1) * 32 + (lane & 3) * 8 + (4 * hi + ((lane & 15) >> 2)) * 64;
    bf16x8 pa[4];
    { v4u w;
      w.x = cvtpk(p0[0], p0[1]); w.y = cvtpk(p0[2], p0[3]); w.z = cvtpk(p0[4], p0[5]); w.w = cvtpk(p0[6], p0[7]); pa[0] = __builtin_bit_cast(bf16x8, w);
      w.x = cvtpk(p0[8], p0[9]); w.y = cvtpk(p0[10], p0[11]); w.z = cvtpk(p0[12], p0[13]); w.w = cvtpk(p0[14], p0[15]); pa[1] = __builtin_bit_cast(bf16x8, w);
      w.x = cvtpk(p1[0], p1[1]); w.y = cvtpk(p1[2], p1[3]); w.z = cvtpk(p1[4], p1[5]); w.w = cvtpk(p1[6], p1[7]); pa[2] = __builtin_bit_cast(bf16x8, w);
      w.x = cvtpk(p1[8], p1[9]); w.y = cvtpk(p1[10], p1[11]); w.z = cvtpk(p1[12], p1[13]); w.w = cvtpk(p1[14], p1[15]); pa[3] = __builtin_bit_cast(bf16x8, w); }
#pragma unroll
    for (int dh = 0; dh < 2; ++dh)
#pragma unroll
        for (int ks = 0; ks < 4; ++ks) {
            const s16x4 lo = vtr(vb + dh * 4096 + ks * 1024), hh = vtr(vb + dh * 4096 + ks * 1024 + 512);
            const bf16x8 vf = (bf16x8){lo[0], lo[1], lo[2], lo[3], hh[0], hh[1], hh[2], hh[3]};
            o[dh] = __builtin_amdgcn_mfma_f32_32x32x16_bf16(vf, pa[ks], o[dh], 0, 0, 0);
        }
}
__device__ __forceinline__ void softmax_pv(f32x16& p0, f32x16& p1, float cadd, bool active, float& m, float& l, f32x16 (&o)[2], const LAS unsigned char* Vimg, int lane) {
    float rm = fmaxf(p0[0], p1[0]);
#pragma unroll
    for (int r = 1; r < 16; ++r) rm = fmaxf(rm, fmaxf(p0[r], p1[r]));
    rm = swapmax(rm) + cadd;
    if (!active) rm = NEGBIG;
    const float mn = fmaxf(m, rm), f = fast_exp2(m - mn); m = mn; l *= f;
    if (__any(f != 1.0f)) {
#pragma unroll
        for (int r = 0; r < 16; ++r) { o[0][r] *= f; o[1][r] *= f; }
    }
    const float sub = active ? mn - cadd : 1e30f;
    float s = 0.f;
#pragma unroll
    for (int r = 0; r < 16; ++r) { p0[r] = fast_exp2(p0[r] - sub); p1[r] = fast_exp2(p1[r] - sub); s += p0[r] + p1[r]; }
    l += s;
    pv(o, Vimg, lane, p0, p1);
}
__device__ __forceinline__ void acc_out(f32x16 (&oacc)[2], const f32x16 (&o)[2], float sc) {
#pragma unroll
    for (int r = 0; r < 16; ++r) { oacc[0][r] += o[0][r] * sc; oacc[1][r] += o[1][r] * sc; }
}
__device__ __forceinline__ void store_o(bf16* dst, const f32x16 (&o)[2], int hi) {
#pragma unroll
    for (int dh = 0; dh < 2; ++dh)
#pragma unroll
        for (int i = 0; i < 4; ++i) { v2u w; w.x = cvtpk(o[dh][4 * i], o[dh][4 * i + 1]); w.y = cvtpk(o[dh][4 * i + 2], o[dh][4 * i + 3]);
            *(GAS v2u*)(dst + 32 * dh + 8 * i + 4 * hi) = w; }
}
struct TileIter {
    unsigned um; int j, jt0, kind, n;
    __device__ __forceinline__ void init(unsigned um_, int j_) { um = um_; j = j_; jt0 = j_ >= 8 ? j_ - 8 : 0; kind = 0; n = -1; }
    __device__ __forceinline__ bool advance() {
        if (kind == 0) { const unsigned rest = (n >= 31) ? 0u : ((um >> (n + 1)) << (n + 1));
            if (rest) { n = __builtin_ctz(rest); return true; }
            kind = 1; n = jt0; return true; }
        ++n; return n <= j;
    }
};

__device__ __forceinline__ void nsa_unit(Frame& F, unsigned char* ws, const float* rel_bias, int b, int g, int j) {
    LAS unsigned char* lds = F.lds;
    const int tid = F.tid, lane = F.lane, w = F.wave, r32 = lane & 31, hi = lane >> 5;
    const int tl = r32 >> 2, hd = r32 & 3, tokl = 8 * w + tl, t = 64 * j + tokl, head = 4 * g + hd;
    const size_t row = (size_t)b * SEQ + t;
    const bf16* QN = (const bf16*)(ws + WS_QN); const bf16* KV = (const bf16*)(ws + WS_KV); const float* GN = (const float*)(ws + WS_GN);
    LAS float* biasS = (LAS float*)(lds + L_BIAS); LAS unsigned* wmask = (LAS unsigned*)(lds + L_WMASK);
    const bool two = j >= 16;
    __syncthreads();
    for (int i = tid; i < 4 * 129; i += 512) { const int h = i / 129, d = i % 129; biasS[h * 132 + d] = rel_bias[T5B[d] * 8 + 4 * g + h] * LOG2E; }
    { const bf16* kc = (const bf16*)(ws + WS_KC) + (size_t)(b * 2 + g) * 128 * 64; const bf16* vc = (const bf16*)(ws + WS_VC) + (size_t)(b * 2 + g) * 128 * 64;
      const v4u a0 = ld_piece(kc, tid), c0 = ld_piece(vc, tid); st_kimg(lds + L_K0, tid, a0); st_vimg(lds + L_V0, tid, c0);
      if (two) { const v4u a1 = ld_piece(kc + 4096, tid), c1 = ld_piece(vc + 4096, tid); st_kimg(lds + L_K1, tid, a1); st_vimg(lds + L_V1, tid, c1); } }
    bf16x8 qr[4];
    { const bf16* qp = QN + row * 512 + head * 64;
#pragma unroll
      for (int d0 = 0; d0 < 4; ++d0) qr[d0] = *(const GAS bf16x8*)(qp + 16 * d0 + 8 * hi); }
    const float g_cmp = GN[row * 24 + head * 3 + 0], g_sel = GN[row * 24 + head * 3 + 1], g_win = GN[row * 24 + head * 3 + 2];
    __syncthreads();
    const LAS float* bh = biasS + hd * 132;
    const float bias_far = bh[128];
    f32x16 oacc[2]; oacc[0] = f32x16{}; oacc[1] = f32x16{};
    unsigned mymask = 1u | (1u << j);
    {
        f32x16 s[4];
        qkt(s[0], s[1], lds + L_K0, qr, r32, hi);
        if (two) qkt(s[2], s[3], lds + L_K1, qr, r32, hi); else { s[2] = f32x16{}; s[3] = f32x16{}; }
        float mx = NEGBIG;
#pragma unroll
        for (int q = 0; q < 4; ++q)
#pragma unroll
            for (int r = 0; r < 16; ++r) { const int c = 32 * q + crow(r, hi); const int dist = t - 16 * c - 31;
                const float bv = bh[dist > 128 ? 128 : (dist < 0 ? 0 : dist)];
                const float v = dist >= 0 ? s[q][r] + bv : NEGBIG; s[q][r] = v; mx = fmaxf(mx, v); }
        mx = swapmax(mx);
        const bool anyv = mx > -1e29f;
        const float sub = anyv ? mx : 1e30f;
        float sum = 0.f;
#pragma unroll
        for (int q = 0; q < 4; ++q)
#pragma unroll
            for (int r = 0; r < 16; ++r) { const float p = fast_exp2(s[q][r] - sub); s[q][r] = p; sum += p; }
        sum = swapsum(sum);
        const float inv = anyv ? 1.0f / sum : 0.f;
#pragma unroll
        for (int q = 0; q < 4; ++q)
#pragma unroll
            for (int r = 0; r < 16; ++r) s[q][r] *= inv;
        float val[16];
#pragma unroll
        for (int q = 0; q < 4; ++q)
#pragma unroll
            for (int i = 0; i < 4; ++i) val[4 * q + i] = (s[q][4 * i] + s[q][4 * i + 1]) + (s[q][4 * i + 2] + s[q][4 * i + 3]);
#pragma unroll
        for (int u = 0; u < 16; ++u) {
            const float lastu = s[u >> 2][4 * (u & 3) + 3];
            auto rr = __builtin_amdgcn_permlane32_swap(__float_as_uint(lastu), __float_as_uint(lastu), false, false);
            if (hi) val[u] += __uint_as_float(rr[0]); else if (u + 1 < 16) val[u + 1] += __uint_as_float(rr[1]);
        }
#pragma unroll
        for (int u = 0; u < 16; ++u) { val[u] += __shfl_xor(val[u], 1); val[u] += __shfl_xor(val[u], 2); }
        {
            unsigned b1 = 0u, b2 = 0u;
#pragma unroll
            for (int u = 0; u < 16; ++u) { const int n = 2 * u + hi; const unsigned key = (n >= 1 && n < j) ? ((__float_as_uint(val[u]) & ~31u) | (unsigned)(31 - n)) : 0u;
                const unsigned lo = b1 < key ? b1 : key; b1 = b1 < key ? key : b1; b2 = b2 < lo ? lo : b2; }
            auto ra = __builtin_amdgcn_permlane32_swap(b1, b1, false, false); auto rb = __builtin_amdgcn_permlane32_swap(b2, b2, false, false);
            const unsigned a1 = ra[0], c1 = ra[1], a2 = rb[0], c2 = rb[1];
            const unsigned t1 = a1 > c1 ? a1 : c1, lo1 = a1 > c1 ? c1 : a1, hi2 = a2 > c2 ? a2 : c2, t2 = lo1 > hi2 ? lo1 : hi2;
            if (t1) mymask |= 1u << (31 - (t1 & 31u));
            if (t2) mymask |= 1u << (31 - (t2 & 31u));
        }
        f32x16 o[2]; o[0] = f32x16{}; o[1] = f32x16{};
        pv(o, lds + L_V0, lane, s[0], s[1]);
        if (two) pv(o, lds + L_V1, lane, s[2], s[3]);
        acc_out(oacc, o, g_cmp);
    }
    unsigned wm = mymask;
#pragma unroll
    for (int o_ = 1; o_ < 64; o_ <<= 1) wm |= (unsigned)__shfl_xor((int)wm, o_);
    if (lane == 0) wmask[w] = wm;
    __syncthreads();
    unsigned um = 0;
#pragma unroll
    for (int i = 0; i < 8; ++i) um |= wmask[i];
    um = (unsigned)__builtin_amdgcn_readfirstlane((int)um);
    wm = (unsigned)__builtin_amdgcn_readfirstlane((int)wm);
    {
        const size_t slab = (size_t)(b * 2 + g) * SEQ * 64;
        const bf16* ks = KV + 2 * KVARR + slab; const bf16* vs = KV + 3 * KVARR + slab; const bf16* kw = KV + 4 * KVARR + slab; const bf16* vw = KV + 5 * KVARR + slab;
        float m = NEGBIG, l = 0.f; f32x16 o[2]; o[0] = f32x16{}; o[1] = f32x16{};
        TileIter cur; cur.init(um, j); cur.advance();
        v4u ka = ld_piece((cur.kind ? kw : ks) + (size_t)cur.n * 4096, tid), va = ld_piece((cur.kind ? vw : vs) + (size_t)cur.n * 4096, tid);
        int buf = 0; bool more = true;
        while (more) {
            LAS unsigned char* Kb = lds + (buf ? L_K1 : L_K0); LAS unsigned char* Vb = lds + (buf ? L_V1 : L_V0);
            st_kimg(Kb, tid, ka); st_vimg(Vb, tid, va);
            TileIter nxt = cur; more = nxt.advance();
            if (more) { ka = ld_piece((nxt.kind ? kw : ks) + (size_t)nxt.n * 4096, tid); va = ld_piece((nxt.kind ? vw : vs) + (size_t)nxt.n * 4096, tid); }
            __syncthreads();
            const int n = cur.n;
            if (cur.kind == 0) {
                if ((wm >> n) & 1u) {
                    f32x16 p0, p1; qkt(p0, p1, Kb, qr, r32, hi);
                    const bool sel = (mymask >> n) & 1u;
                    if (j - n >= 3) softmax_pv(p0, p1, bias_far, sel, m, l, o, Vb, lane);
                    else {
                        const int dbase = t - 64 * n - 4 * hi;
#pragma unroll
                        for (int r = 0; r < 16; ++r) { const int d0 = dbase - ((r & 3) + 8 * (r >> 2)), d1 = d0 - 32;
                            const float b0 = bh[d0 > 128 ? 128 : (d0 < 0 ? 0 : d0)], b1_ = bh[d1 > 128 ? 128 : (d1 < 0 ? 0 : d1)];
                            p0[r] = d0 >= 0 ? p0[r] + b0 : NEGBIG; p1[r] = d1 >= 0 ? p1[r] + b1_ : NEGBIG; }
                        softmax_pv(p0, p1, 0.f, sel, m, l, o, Vb, lane);
                    }
                }
                if (nxt.kind == 1) {
                    l = swapsum(l); acc_out(oacc, o, g_sel / l);
                    m = NEGBIG; l = 0.f; o[0] = f32x16{}; o[1] = f32x16{};
                }
            } else {
                f32x16 p0, p1; qkt(p0, p1, Kb, qr, r32, hi);
                if (j - n >= 3 && j - n < 8) softmax_pv(p0, p1, bias_far, true, m, l, o, Vb, lane);
                else {
                    const int dbase = t - 64 * n - 4 * hi;
#pragma unroll
                    for (int r = 0; r < 16; ++r) { const int d0 = dbase - ((r & 3) + 8 * (r >> 2)), d1 = d0 - 32;
                        const float b0 = bh[d0 > 128 ? 128 : (d0 < 0 ? 0 : d0)], b1_ = bh[d1 > 128 ? 128 : (d1 < 0 ? 0 : d1)];
                        p0[r] = (d0 >= 0 && d0 < 512) ? p0[r] + b0 : NEGBIG; p1[r] = (d1 >= 0 && d1 < 512) ? p1[r] + b1_ : NEGBIG; }
                    softmax_pv(p0, p1, 0.f, true, m, l, o, Vb, lane);
                }
            }
            cur = nxt; buf ^= 1;
        }
        l = swapsum(l);
        acc_out(oacc, o, g_win / l);
    }
    store_o((bf16*)(ws + WS_ONSA) + row * 512 + head * 64, oacc, hi);
}

__device__ __forceinline__ void sb_unit(Frame& F, unsigned char* ws, int b, int h, int qb) {
    LAS unsigned char* lds = F.lds;
    const int tid = F.tid, lane = F.lane, w = F.wave, r32 = lane & 31, hi = lane >> 5;
    const int t = 256 * qb + 32 * w + r32;
    const bf16* SBQ = (const bf16*)(ws + WS_SB) + (size_t)(b * 8 + h) * SEQ * 64; const bf16* SBK = SBQ + SBARR; const bf16* SBV = SBQ + 2 * SBARR;
    LAS unsigned* donef = (LAS unsigned*)(lds + L_DONE);
    bf16x8 qr[4];
#pragma unroll
    for (int d0 = 0; d0 < 4; ++d0) qr[d0] = *(const GAS bf16x8*)(SBQ + (size_t)t * 64 + 16 * d0 + 8 * hi);
    f32x16 o[2]; o[0] = f32x16{}; o[1] = f32x16{};
    float C = 0.f;
    bool done = false;
    const int ktop = 4 * qb + 3, kmine = 4 * qb + (w >> 1);
    __syncthreads();
    v4u ka = ld_piece(SBK + (size_t)ktop * 4096, tid), va = ld_piece(SBV + (size_t)ktop * 4096, tid);
    int buf = 0;
    for (int kt = ktop; kt >= 0; --kt) {
        LAS unsigned char* Kb = lds + (buf ? L_K1 : L_K0); LAS unsigned char* Vb = lds + (buf ? L_V1 : L_V0);
        st_kimg(Kb, tid, ka); st_vimg(Vb, tid, va);
        if (lane == 0) donef[buf * 8 + w] = done ? 1u : 0u;
        if (kt > 0) { ka = ld_piece(SBK + (size_t)(kt - 1) * 4096, tid); va = ld_piece(SBV + (size_t)(kt - 1) * 4096, tid); }
        __syncthreads();
        unsigned nd = 0;
#pragma unroll
        for (int i = 0; i < 8; ++i) nd += donef[buf * 8 + i];
        buf ^= 1;
        if (__builtin_amdgcn_readfirstlane((int)nd) == 8) break;
        if (done || kt > kmine) continue;
        f32x16 z0, z1; qkt(z0, z1, Kb, qr, r32, hi);
        const int kb0 = 64 * kt + 4 * hi;
        f32x16 lb0, lb1;
        if (kt == kmine) {
#pragma unroll
            for (int r = 0; r < 16; ++r) {
                { const float z = z0[r], e = fast_exp2(-fabsf(z)), L = __builtin_amdgcn_logf(1.0f + e); const bool ok = kb0 + (r & 3) + 8 * (r >> 2) < t;
                  lb0[r] = ok ? fminf(z, 0.f) - L : NEGBIG; z0[r] = ok ? -fmaxf(z, 0.f) - L : 0.f; }
                { const float z = z1[r], e = fast_exp2(-fabsf(z)), L = __builtin_amdgcn_logf(1.0f + e); const bool ok = kb0 + 32 + (r & 3) + 8 * (r >> 2) < t;
                  lb1[r] = ok ? fminf(z, 0.f) - L : NEGBIG; z1[r] = ok ? -fmaxf(z, 0.f) - L : 0.f; }
            }
        } else {
#pragma unroll
            for (int r = 0; r < 16; ++r) {
                { const float z = z0[r], e = fast_exp2(-fabsf(z)), L = __builtin_amdgcn_logf(1.0f + e); lb0[r] = fminf(z, 0.f) - L; z0[r] = -fmaxf(z, 0.f) - L; }
                { const float z = z1[r], e = fast_exp2(-fabsf(z)), L = __builtin_amdgcn_logf(1.0f + e); lb1[r] = fminf(z, 0.f) - L; z1[r] = -fmaxf(z, 0.f) - L; }
            }
        }
        float gs[8];
#pragma unroll
        for (int i = 0; i < 4; ++i) { gs[i] = (z0[4 * i] + z0[4 * i + 1]) + (z0[4 * i + 2] + z0[4 * i + 3]); gs[4 + i] = (z1[4 * i] + z1[4 * i + 1]) + (z1[4 * i + 2] + z1[4 * i + 3]); }
        float E[8]; float run = 0.f;
#pragma unroll
        for (int u = 7; u >= 0; --u) {
            auto rr = __builtin_amdgcn_permlane32_swap(__float_as_uint(gs[u]), __float_as_uint(gs[u]), false, false);
            const float g0 = __uint_as_float(rr[0]), g1 = __uint_as_float(rr[1]);
            const float e1 = run; run += g1; const float e0 = run; run += g0;
            E[u] = hi ? e1 : e0;
        }
#pragma unroll
        for (int i = 0; i < 4; ++i) {
            { float later = C + E[i];
              const float a3 = fast_exp2(lb0[4 * i + 3] + later); later += z0[4 * i + 3];
              const float a2 = fast_exp2(lb0[4 * i + 2] + later); later += z0[4 * i + 2];
              const float a1 = fast_exp2(lb0[4 * i + 1] + later); later += z0[4 * i + 1];
              const float a0 = fast_exp2(lb0[4 * i] + later);
              z0[4 * i] = a0; z0[4 * i + 1] = a1; z0[4 * i + 2] = a2; z0[4 * i + 3] = a3; }
            { float later = C + E[4 + i];
              const float a3 = fast_exp2(lb1[4 * i + 3] + later); later += z1[4 * i + 3];
              const float a2 = fast_exp2(lb1[4 * i + 2] + later); later += z1[4 * i + 2];
              const float a1 = fast_exp2(lb1[4 * i + 1] + later); later += z1[4 * i + 1];
              const float a0 = fast_exp2(lb1[4 * i] + later);
              z1[4 * i] = a0; z1[4 * i + 1] = a1; z1[4 * i + 2] = a2; z1[4 * i + 3] = a3; }
        }
        C += run;
        pv(o, Vb, lane, z0, z1);
        done = __all(C < -151.0f);
    }
    store_o((bf16*)(ws + WS_OSB) + ((size_t)b * SEQ + t) * 512 + h * 64, o, hi);
}

__device__ __forceinline__ float gelu_tanh(float x) {
    const float u = 0.7978845608028654f * (x + 0.044715f * x * x * x);
    const float e = fast_exp2(2.0f * LOG2E * u);
    const float th = 1.0f - 2.0f * __builtin_amdgcn_rcpf(e + 1.0f);
    return 0.5f * x * (1.0f + th);
}
__device__ __forceinline__ void cmp_unit(Frame& F, unsigned char* ws, const float* b1, int kv, int b, int g, int cc) {
    LAS unsigned char* lds = F.lds;
    const int tid = F.tid, lane = F.lane, w = F.wave, r32 = lane & 31, hi = lane >> 5;
    const bf16* src = (const bf16*)(ws + WS_KV) + (size_t)kv * KVARR + (size_t)(b * 2 + g) * SEQ * 64 + (size_t)(512 * cc) * 64;
    const bf16* W1T = (const bf16*)(ws + (kv ? WS_CW1V : WS_CW1K)); const bf16* W2T = (const bf16*)(ws + (kv ? WS_CW2V : WS_CW2K));
    const float* b1p = (const float*)(ws + WS_B1P) + kv * 256;
    bf16* dst = (bf16*)(ws + (kv ? WS_VC : WS_KC)) + (size_t)(b * 2 + g) * 128 * 64;
    LAS bf16* hid = (LAS bf16*)(lds + L_HID);
    __syncthreads();
    for (int p = tid; p < 528 * 8; p += 512) { const int tok = p >> 3, ch = p & 7;
        const v4u v = *(const GAS v4u*)((const GAS char*)src + (size_t)p * 16);
        *(LAS v4u*)(lds + L_CA + tok * 128 + ((ch ^ ((tok >> 4) & 7)) * 16)) = v; }
    __syncthreads();
    f32x16 acc = {};
    const bf16* brow = W1T + (size_t)(32 * w + r32) * 2048 + 8 * hi;
#pragma unroll 4
    for (int ks = 0; ks < 128; ++ks) {
        const int l = ks >> 2, ch = 2 * (ks & 3) + hi, tok = 16 * r32 + l;
        const bf16x8 af = *(const LAS bf16x8*)(lds + L_CA + tok * 128 + ((ch ^ ((tok >> 4) & 7)) * 16));
        const bf16x8 bf = *(const GAS bf16x8*)(brow + 16 * ks);
        acc = __builtin_amdgcn_mfma_f32_32x32x16_bf16(af, bf, acc, 0, 0, 0);
    }
    { const float bias = b1[32 * w + r32] + b1p[32 * w + r32];
#pragma unroll
      for (int r = 0; r < 16; ++r) hid[crow(r, hi) * 264 + 32 * w + r32] = (bf16)f2bf(gelu_tanh(acc[r] + bias)); }
    __syncthreads();
    if (w < 2) {
        f32x16 o = {};
        const LAS bf16* hrow = hid + r32 * 264 + 8 * hi;
        const bf16* w2row = W2T + (size_t)(32 * w + r32) * 256 + 8 * hi;
#pragma unroll
        for (int ks = 0; ks < 16; ++ks) {
            const bf16x8 af = *(const LAS bf16x8*)(hrow + 16 * ks);
            const bf16x8 bf = *(const GAS bf16x8*)(w2row + 16 * ks);
            o = __builtin_amdgcn_mfma_f32_32x32x16_bf16(af, bf, o, 0, 0, 0);
        }
#pragma unroll
        for (int r = 0; r < 16; ++r) { const int cr = 32 * cc + crow(r, hi); dst[(size_t)cr * 64 + 32 * w + r32] = (bf16)(cr < 127 ? f2bf(o[r]) : 0u); }
    }
}
}

__device__ __forceinline__ void final_norm_row(int lane, float* xrow, const float* g) {
    GAS f32x4* xr = (GAS f32x4*)xrow + lane; const GAS f32x4* gr = (const GAS f32x4*)g + lane;
    f32x4 v[4]; float s = 0.f;
#pragma unroll
    for (int j = 0; j < 4; ++j) { v[j] = xr[64 * j]; s += (v[j].x * v[j].x + v[j].y * v[j].y) + (v[j].z * v[j].z + v[j].w * v[j].w); }
    const float rstd = 1.f / sqrtf(wave_sum(s) * (1.f / DM) + EPS);
#pragma unroll
    for (int j = 0; j < 4; ++j) { const f32x4 gg = gr[64 * j]; xr[64 * j] = v[j] * rstd * gg; }
}

struct Args { In in; float* out; unsigned char* ws; int ph_lo, ph_hi, li, pad; };
__global__ void __launch_bounds__(NWAVES * 64, 2) fwd_kernel(Args args) {
    extern __shared__ __attribute__((aligned(16))) unsigned char lds[];
    Frame F;
    F.lds = (LAS unsigned char*)lds;
    F.MISC = (volatile LAS unsigned*)(F.lds + MISC_OFF);
    F.tid = threadIdx.x; F.lane = F.tid & 63; F.wave = __builtin_amdgcn_readfirstlane(F.tid >> 6);
    F.G = gridDim.x; { const int bx = blockIdx.x; F.vcu = (F.G % 8 == 0) ? (bx % 8) * (F.G / 8) + bx / 8 : bx; }
    unsigned char* ws = args.ws;
    F.ctl = (gu32*)(ws + WS_CTL);
    for (int u = F.tid; u < (LDS_BYTES - LDSCTL_OFF) / 4; u += NWAVES * 64) ((LAS unsigned*)(F.lds + LDSCTL_OFF))[u] = 0u;
    __syncthreads();
    constexpr bool PER_PHASE = (MK_N_LAUNCHES != 1);
    XcdBarrier bar; bar.bar = (unsigned*)(F.ctl + CW_BAR); bar.x = 0; bar.st = nullptr;
    if (!PER_PHASE) bar = xcd_barrier_post((unsigned*)(F.ctl + CW_BAR), F.MISC + 8);
#define GRID_BAR() do { if (!PER_PHASE) xcd_barrier(bar); } while (0)
    const int lo = args.ph_lo, hi = args.ph_hi;
#define IN(k) (lo <= (k) && (k) < hi)
#define BOTH(k) (IN(k) && IN((k) + 1))
    const In& in = args.in;
    bf16* XN = (bf16*)(ws + WS_XN);

    if (IN(0)) { p0_prologue(F, in, ws); if (BOTH(0)) GRID_BAR(); }
    if (IN(1)) {
        pg8::Gemm g{XN, (const bf16*)(ws + WS_WIN), M, N1, DM}; pg8::StaticOrder S; S.init(M, N1, F.G, (int)blockIdx.x);
        EpiInProj E{(bf16*)(ws + WS_QN), (bf16*)(ws + WS_KV), (bf16*)(ws + WS_SB), (bf16*)(ws + WS_GM), (float*)(ws + WS_GN)};
        pg8::gemm_phase<EpiInProj, pg8::StaticOrder, true, true>(F.lds + RING_OFF, g, S, E);
        if (BOTH(1)) GRID_BAR();
    }
    if (IN(2)) {
        for (int i = F.vcu; i < 256; i += F.G) { const int kv = i >> 7, b = (i >> 3) & 15, g = (i >> 2) & 1, cc = i & 3;
            att::cmp_unit(F, ws, kv ? in.p[10] : in.p[6], kv, b, g, cc); }
        if (BOTH(2)) GRID_BAR();
    }
    if (IN(3)) {
        for (int i = F.vcu; i < 1024; i += F.G) { const int v = i & 255, k = i >> 8, bg = v >> 3, s = v & 7;
            const int j = (k == 0) ? s : (k == 1) ? 15 - s : (k == 2) ? 16 + s : 31 - s;
            att::nsa_unit(F, ws, in.p[3], bg >> 1, bg & 1, j); }
        for (int i = F.vcu; i < 1024; i += F.G) { const int v = i & 255, k = i >> 8, bh = v >> 1, s = v & 1;
            const int qb = (k == 0) ? s : (k == 1) ? 3 - s : (k == 2) ? 4 + s : 7 - s;
            att::sb_unit(F, ws, bh >> 3, bh & 7, qb); }
        __syncthreads();
        if (BOTH(3)) GRID_BAR();
    }
    if (IN(4)) {
        { pg8::Gemm g{(const bf16*)(ws + WS_ONSA), (const bf16*)(ws + WS_WN), M, DM, 512}; pg8::StaticOrder S; S.init(M, DM, F.G, (int)blockIdx.x);
          EpiUp<false> E{(bf16*)(ws + WS_MIX), (const bf16*)(ws + WS_GM)};
          pg8::gemm_phase<EpiUp<false>, pg8::StaticOrder, true, true>(F.lds + RING_OFF, g, S, E); }
        asm volatile("s_waitcnt vmcnt(0)" ::: "memory"); __syncthreads();
        { pg8::Gemm g{(const bf16*)(ws + WS_OSB), (const bf16*)(ws + WS_WSB), M, DM, 512}; pg8::StaticOrder S; S.init(M, DM, F.G, (int)blockIdx.x);
          EpiUp<true> E{(bf16*)(ws + WS_MIX), (const bf16*)(ws + WS_GM) + 1024};
          pg8::gemm_phase<EpiUp<true>, pg8::StaticOrder, true, true>(F.lds + RING_OFF, g, S, E); }
        if (BOTH(4)) GRID_BAR();
    }
    if (IN(5)) {
        pg8::Gemm g{(const bf16*)(ws + WS_MIX), (const bf16*)(ws + WS_WO), M, DM, DM}; pg8::StaticOrder S; S.init(M, DM, F.G, (int)blockIdx.x);
        EpiOut E{in.p[0], args.out, (bf16*)(ws + WS_X1B), (float*)(ws + WS_ROWSS)};
        pg8::gemm_phase<EpiOut, pg8::StaticOrder, true, true>(F.lds + RING_OFF, g, S, E);
        if (BOTH(5)) GRID_BAR();
    }
    if (IN(6)) {
        pg8::Gemm g{(const bf16*)(ws + WS_X1B), (const bf16*)(ws + WS_W1), M, FF, DM}; pg8::StaticOrder S; S.init(M, FF, F.G, (int)blockIdx.x);
        EpiFF1 E{(bf16*)(ws + WS_F), (const float*)(ws + WS_ROWSS)};
        pg8::gemm_phase<EpiFF1, pg8::StaticOrder, true, true>(F.lds + RING_OFF, g, S, E);
        if (BOTH(6)) GRID_BAR();
    }
    if (IN(7)) {
        pg8::Gemm g{(const bf16*)(ws + WS_F), (const bf16*)(ws + WS_W2), M, DM, FF}; pg8::StaticOrder S; S.init(M, DM, F.G, (int)blockIdx.x);
        EpiFF2 E{args.out};
        pg8::gemm_phase<EpiFF2, pg8::StaticOrder, true, true>(F.lds + RING_OFF, g, S, E);
        if (BOTH(7)) GRID_BAR();
    }
    if (IN(8)) {
        const int gw = F.vcu * NWAVES + F.wave, NGW = F.G * NWAVES;
        const int lane8 = (int)__builtin_amdgcn_mbcnt_hi(~0u, __builtin_amdgcn_mbcnt_lo(~0u, 0u));
        for (int m = gw; m < M; m += NGW) final_norm_row(lane8, args.out + (size_t)m * DM, in.p[18]);
    }
#undef IN
#undef BOTH
}

extern "C" void kernel_launch(void* const* d_in, const int* in_sizes, int n_in, void* d_out, int out_size, void* d_ws, size_t ws_size, hipStream_t stream) {
    static int grid = 0;
    if (grid == 0) {
        if (n_in != 19 || in_sizes[0] != M * DM || out_size != M * DM || ws_size < WS_END) { fprintf(stderr, "kernel_launch: unexpected shapes (n_in %d, in0 %d, out %d, ws %zu); nothing launched\n", n_in, n_in > 0 ? in_sizes[0] : -1, out_size, ws_size); grid = -1; return; }
        int dev = 0, cus = 0, per_cu = 0;
        if (hipGetDevice(&dev) != hipSuccess || hipDeviceGetAttribute(&cus, hipDeviceAttributeMultiprocessorCount, dev) != hipSuccess) { grid = -1; return; }
        if (hipFuncSetAttribute((const void*)fwd_kernel, hipFuncAttributeMaxDynamicSharedMemorySize, LDS_BYTES) != hipSuccess) { fprintf(stderr, "kernel_launch: hipFuncSetAttribute failed\n"); grid = -1; return; }
        if (hipOccupancyMaxActiveBlocksPerMultiprocessor(&per_cu, (const void*)fwd_kernel, NWAVES * 64, LDS_BYTES) != hipSuccess || per_cu < 1) { fprintf(stderr, "kernel_launch: occupancy query reports %d blocks per CU\n", per_cu); per_cu = 1; }
        (void)hipGetLastError();
        grid = cus;
    }
    if (grid < 0) return;
    (void)hipMemsetAsync((char*)d_ws + WS_CTL, 0, CTL_ZERO_BYTES, stream);
    Args a{};
    for (int i = 0; i < 19; ++i) a.in.p[i] = (const float*)d_in[i];
    a.out = (float*)d_out; a.ws = (unsigned char*)d_ws;
    if (MK_N_LAUNCHES == 1) {
        a.ph_lo = 0; a.ph_hi = N_PHASES; a.li = 0;
        hipLaunchKernelGGL(fwd_kernel, dim3(grid), dim3(NWAVES * 64), LDS_BYTES, stream, a);
    } else {
        for (int li = 0; li < 9; ++li) { a.ph_lo = li; a.ph_hi = li + 1; a.li = li;
            hipLaunchKernelGGL(fwd_kernel, dim3(grid), dim3(NWAVES * 64), LDS_BYTES, stream, a); }
    }
}
```

```cpp
#include <hip/hip_runtime.h>
#include <cstdio>
#include <cstdint>
namespace pg8 {
#define PG8_LAS __attribute__((address_space(3)))
typedef unsigned short bf16_t;
typedef short bf16x8 __attribute__((ext_vector_type(8)));
typedef float f32x4 __attribute__((ext_vector_type(4)));
typedef unsigned u32x4 __attribute__((ext_vector_type(4)));
constexpr int BM = 256, BK = 64, HALF = 128, HTB = HALF * BK * 2  , STAGE_BYTES = 8 * HTB, NXCD = 8, WGM = 8;

__host__ __device__ __forceinline__ int lds_byte(int r, int c) { const int st = (r >> 4) * 2 + (c >> 5), rr = r & 15, cc = c & 31, ob = rr * 64 + cc * 2; return st * 1024 + (ob ^ (((ob >> 9) & 1) << 5)); }
__host__ __device__ __forceinline__ void stage_rc(int b, int& R, int& C) { const int st = b / 1024, sb = b % 1024, swz = sb ^ (((sb >> 9) & 1) << 5); R = (st >> 1) * 16 + swz / 64; C = (st & 1) * 32 + (swz % 64) / 2; }
__host__ __device__ __forceinline__ int perm32(int rho) { const int n = rho >> 4, i = rho & 15; return 8 * (i >> 2) + 4 * n + (i & 3); }

struct Unit { int pm, pn; };
struct Gemm { const bf16_t* A; const bf16_t* Bt; int M, N, K; };

struct StaticOrder {
    int nM, nN, nwg, G, c;
    __host__ __device__ void init(int M, int N, int G_, int c_) { nM = M / BM; nN = N / BM; nwg = nM * nN; G = G_; c = c_; }
    __host__ __device__ bool next(int i, Unit& u) const {
        const long L = (long)i * G + c; if (L >= nwg) return false;
        int wgid = (int)L; { const int q = nwg / NXCD, r = nwg % NXCD, xcd = wgid % NXCD, off = wgid / NXCD; wgid = (xcd < r ? xcd * (q + 1) : r * (q + 1) + (xcd - r) * q) + off; }
        const int nig = WGM * nN, gid = wgid / nig, fm = gid * WGM, gsz = (nM - fm) < WGM ? (nM - fm) : WGM;
        u.pm = fm + ((wgid % nig) % gsz); u.pn = (wgid % nig) / gsz; return true;
    }
    __device__ __forceinline__ void a_ready(const Unit&) const {}
    __device__ __forceinline__ void done(const Unit&) const {}
};

__device__ __forceinline__ unsigned cvt_pk_bf16(float lo, float hi) { unsigned r; asm volatile("v_cvt_pk_bf16_f32 %0, %1, %2" : "=v"(r) : "v"(lo), "v"(hi)); return r; }
typedef float f32x2 __attribute__((ext_vector_type(2)));
template <class Epi, class Sched, bool ALIGN_EPI = false, bool SP2 = false>
__device__ __forceinline__ void gemm_phase(PG8_LAS unsigned char* lds, const Gemm g, const Sched& S, const Epi& E) {
    const int tid = threadIdx.x, wid = __builtin_amdgcn_readfirstlane(tid >> 6), lane = tid & 63, wr = wid >> 2, wc = wid & 3, fr = lane & 15, fq = lane >> 4;
    const int K = g.K, nt = K / BK;
    unsigned voffA[2], voffB[2];
#pragma unroll
    for (int i = 0; i < 2; ++i) { int R, C; stage_rc(tid * 16 + i * 8192, R, C); const int Rb = Epi::PERM ? ((R & ~31) + perm32(R & 31)) : R;
        voffA[i] = (unsigned)(R * K + C) * 2u; voffB[i] = (unsigned)(Rb * K + C) * 2u; }
    const size_t kstep = (size_t)(BK * 2);
    const size_t hstep = (size_t)HALF * K * 2;
    const size_t tstep = 2 * hstep;
    const unsigned ldsw = (unsigned)wid * 1024u;
    const int aoff = lds_byte(wr * 64 + fr, fq * 8), boff = lds_byte(wc * 32 + fr, fq * 8);
#define PG8_SA(b, h) (((b) * 2 + (h)) * HTB)
#define PG8_SB(b, h) ((4 + (b) * 2 + (h)) * HTB)
#define PG8_STAGE(bufoff, gbase, voff) do { _Pragma("unroll") for (int _i = 0; _i < 2; ++_i) \
        __builtin_amdgcn_global_load_lds((const unsigned*)((const char*)(gbase) + (voff)[_i]), (PG8_LAS unsigned*)(lds + (bufoff) + ldsw + _i * 8192), 16, 0, 0); } while (0)
#define PG8_LDA(dst, b, h) do { _Pragma("unroll") for (int m = 0; m < 4; ++m) _Pragma("unroll") for (int k = 0; k < 2; ++k) dst[m][k] = *(const PG8_LAS bf16x8*)(lds + PG8_SA(b, h) + aoff + m * 2048 + k * 1024); } while (0)
#define PG8_LDB(dst, b, h) do { _Pragma("unroll") for (int n = 0; n < 2; ++n) _Pragma("unroll") for (int k = 0; k < 2; ++k) dst[n][k] = *(const PG8_LAS bf16x8*)(lds + PG8_SB(b, h) + boff + n * 2048 + k * 1024); } while (0)
#define PG8_MMA(ai, bj, At, Bt) do { __builtin_amdgcn_s_setprio(1); _Pragma("unroll") for (int m = 0; m < 4; ++m) _Pragma("unroll") for (int n = 0; n < 2; ++n) _Pragma("unroll") for (int k = 0; k < 2; ++k) \
        acc[ai][bj][m][n] = __builtin_amdgcn_mfma_f32_16x16x32_bf16(Bt[n][k], At[m][k], acc[ai][bj][m][n], 0, 0, 0); __builtin_amdgcn_s_setprio(0); } while (0)
#define PG8_WAIT_V(n) asm volatile("s_waitcnt vmcnt(" #n ")" ::: "memory")
#define PG8_WAIT_L(n) asm volatile("s_waitcnt lgkmcnt(" #n ")" ::: "memory")
#define PG8_BAR __builtin_amdgcn_s_barrier()
#define PG8_SCHED __builtin_amdgcn_sched_barrier(0)
    Unit cur, nxt; int ui = 0;
    if (!S.next(0, cur)) return;
    f32x4 acc[2][2][4][2];
#pragma unroll
    for (int a = 0; a < 2; ++a)
#pragma unroll
        for (int b = 0; b < 2; ++b)
#pragma unroll
            for (int m = 0; m < 4; ++m)
#pragma unroll
                for (int n = 0; n < 2; ++n) acc[a][b][m][n] = (f32x4){0.f, 0.f, 0.f, 0.f};
    bf16x8 At[4][2], B0[2][2], B1[2][2];
    const char* cA = (const char*)g.A + (size_t)cur.pm * tstep; const char* cB = (const char*)g.Bt + (size_t)cur.pn * tstep;
    S.a_ready(cur);
    if constexpr (SP2) {
        PG8_STAGE(PG8_SB(0, 0), cB, voffB); PG8_STAGE(PG8_SB(0, 1), cB + hstep, voffB); PG8_STAGE(PG8_SA(0, 0), cA, voffA); PG8_STAGE(PG8_SA(0, 1), cA + hstep, voffA);
        if (wr == 1) PG8_BAR;
        PG8_WAIT_V(2); PG8_BAR;
        PG8_STAGE(PG8_SB(1, 0), cB + kstep, voffB); PG8_STAGE(PG8_SA(1, 0), cA + kstep, voffA); PG8_STAGE(PG8_SB(1, 1), cB + hstep + kstep, voffB);
        PG8_WAIT_V(6); PG8_BAR;
    } else {
        PG8_STAGE(PG8_SB(0, 0), cB, voffB); PG8_STAGE(PG8_SA(0, 0), cA, voffA); PG8_STAGE(PG8_SB(0, 1), cB + hstep, voffB); PG8_STAGE(PG8_SA(0, 1), cA + hstep, voffA);
        if (wr == 1) PG8_BAR;
        PG8_WAIT_V(4); PG8_BAR;
        PG8_STAGE(PG8_SB(1, 0), cB + kstep, voffB); PG8_STAGE(PG8_SA(1, 0), cA + kstep, voffA); PG8_STAGE(PG8_SB(1, 1), cB + hstep + kstep, voffB);
        PG8_WAIT_V(6); PG8_BAR;
    }
    for (;;) {
        const bool has_next = S.next(ui + 1, nxt);
        const char* nA = has_next ? (const char*)g.A + (size_t)nxt.pm * tstep : cA; const char* nB = has_next ? (const char*)g.Bt + (size_t)nxt.pn * tstep : cB;
        for (int t = 0; t < nt; t += 2) {
            const bool last = (t == nt - 2);
            const char* a1 = cA + (size_t)(t + 1) * kstep;
            const char* a2 = last ? nA : cA + (size_t)(t + 2) * kstep; const char* b2 = last ? nB : cB + (size_t)(t + 2) * kstep;
            const char* a3 = a2 + kstep; const char* b3 = b2 + kstep;
            if (last && has_next) S.a_ready(nxt);
            if constexpr (SP2) {
            PG8_LDB(B0, 0, 0); PG8_LDB(B1, 0, 1); PG8_SCHED; PG8_LDA(At, 0, 0); PG8_STAGE(PG8_SA(1, 1), a1 + hstep, voffA);
            PG8_WAIT_V(8); PG8_WAIT_L(0); PG8_BAR; PG8_MMA(0, 0, At, B0); PG8_MMA(0, 1, At, B1); PG8_BAR; PG8_SCHED;
            PG8_LDA(At, 0, 1); PG8_STAGE(PG8_SB(0, 0), b2, voffB); PG8_STAGE(PG8_SB(0, 1), b2 + hstep, voffB); PG8_STAGE(PG8_SA(0, 0), a2, voffA);
            PG8_WAIT_V(8); PG8_WAIT_L(0); PG8_BAR; PG8_MMA(1, 0, At, B0); PG8_MMA(1, 1, At, B1); PG8_BAR; PG8_SCHED;
            PG8_LDB(B0, 1, 0); PG8_LDB(B1, 1, 1); PG8_SCHED; PG8_LDA(At, 1, 0); PG8_STAGE(PG8_SA(0, 1), a2 + hstep, voffA);
            PG8_WAIT_V(8); PG8_WAIT_L(0); PG8_BAR; PG8_MMA(0, 0, At, B0); PG8_MMA(0, 1, At, B1); PG8_BAR; PG8_SCHED;
            PG8_LDA(At, 1, 1); PG8_STAGE(PG8_SB(1, 0), b3, voffB); PG8_STAGE(PG8_SB(1, 1), b3 + hstep, voffB); PG8_STAGE(PG8_SA(1, 0), a3, voffA);
            PG8_WAIT_V(8); PG8_WAIT_L(0); PG8_BAR; PG8_MMA(1, 0, At, B0); PG8_MMA(1, 1, At, B1); PG8_BAR; PG8_SCHED;
            } else {
            PG8_LDB(B0, 0, 0); PG8_SCHED; PG8_LDA(At, 0, 0); PG8_STAGE(PG8_SA(1, 1), a1 + hstep, voffA);
            PG8_WAIT_L(8); PG8_BAR; PG8_WAIT_L(0); PG8_MMA(0, 0, At, B0); PG8_BAR; PG8_SCHED;
            PG8_LDB(B1, 0, 1); PG8_STAGE(PG8_SB(0, 0), b2, voffB);
            PG8_BAR; PG8_WAIT_L(0); PG8_MMA(0, 1, At, B1); PG8_BAR;
            PG8_LDA(At, 0, 1); PG8_STAGE(PG8_SA(0, 0), a2, voffA);
            PG8_BAR; PG8_WAIT_L(0); PG8_MMA(1, 0, At, B0); PG8_BAR; PG8_SCHED;
            PG8_STAGE(PG8_SB(0, 1), b2 + hstep, voffB);
            PG8_WAIT_V(6); PG8_BAR; PG8_MMA(1, 1, At, B1); PG8_BAR;
            PG8_LDB(B0, 1, 0); PG8_SCHED; PG8_LDA(At, 1, 0); PG8_STAGE(PG8_SA(0, 1), a2 + hstep, voffA);
            PG8_WAIT_L(8); PG8_BAR; PG8_WAIT_L(0); PG8_MMA(0, 0, At, B0); PG8_BAR; PG8_SCHED;
            PG8_LDB(B1, 1, 1); PG8_STAGE(PG8_SB(1, 0), b3, voffB);
            PG8_BAR; PG8_WAIT_L(0); PG8_MMA(0, 1, At, B1); PG8_BAR;
            PG8_LDA(At, 1, 1); PG8_STAGE(PG8_SA(1, 0), a3, voffA);
            PG8_BAR; PG8_WAIT_L(0); PG8_MMA(1, 0, At, B0); PG8_BAR; PG8_SCHED;
            PG8_STAGE(PG8_SB(1, 1), b3 + hstep, voffB);
            PG8_WAIT_V(6); PG8_BAR; PG8_MMA(1, 1, At, B1); PG8_BAR;
            }
        }
        if constexpr (ALIGN_EPI) { if (wr == 0) PG8_BAR; }
        if constexpr (!Epi::AFTER_DRAIN) { E(acc, cur, wr, wc, fr, fq); S.done(cur); }
        if (!has_next) break;
#pragma unroll
        for (int a = 0; a < 2; ++a)
#pragma unroll
            for (int b = 0; b < 2; ++b)
#pragma unroll
                for (int m = 0; m < 4; ++m)
#pragma unroll
                    for (int n = 0; n < 2; ++n) acc[a][b][m][n] = (f32x4){0.f, 0.f, 0.f, 0.f};
        cur = nxt; cA = nA; cB = nB; ++ui;
        if constexpr (ALIGN_EPI) { if (wr == 1) PG8_BAR; }
    }
    PG8_WAIT_V(0);
    if constexpr (!ALIGN_EPI) { if (wr == 0) PG8_BAR; }
    PG8_BAR;
    if constexpr (Epi::AFTER_DRAIN) { E.fused(acc, cur, wr, wc, fr, fq, lds, wid, lane); S.done(cur); }
#undef PG8_SA
#undef PG8_SB
#undef PG8_STAGE
#undef PG8_LDA
#undef PG8_LDB
#undef PG8_MMA
#undef PG8_WAIT_V
#undef PG8_WAIT_L
#undef PG8_BAR
#undef PG8_SCHED
}
}
#define GAS __attribute__((address_space(1)))
#define LAS __attribute__((address_space(3)))
typedef unsigned short bf16;
typedef unsigned v4u __attribute__((ext_vector_type(4)));
typedef float f32x4 __attribute__((ext_vector_type(4)));
typedef short bf16x8 __attribute__((ext_vector_type(8)));
typedef GAS unsigned gu32;
typedef GAS unsigned long long gu64;
#define RLX_AGENT __ATOMIC_RELAXED, __HIP_MEMORY_SCOPE_AGENT
#define LDS_WAIT() asm volatile("s_waitcnt lgkmcnt(0)" ::: "memory")
#define VM_WAIT() asm volatile("s_waitcnt vmcnt(0)" ::: "memory")
__device__ __forceinline__ unsigned long long rt() { return __builtin_amdgcn_s_memrealtime(); }
__device__ __forceinline__ unsigned f2bf(float f) { unsigned u = __builtin_bit_cast(unsigned, f); return (u + 0x7fffu + ((u >> 16) & 1u)) >> 16; }
__device__ __forceinline__ unsigned pk2(float lo, float hi) { return f2bf(lo) | (f2bf(hi) << 16); }

#define XB_TMO      128
#define XB_XCNT(j)  (256  + 64 * (j))
#define XB_XSUB(j)  (1280 + 64 * (j))
#define XB_XGEN(j)  (2304 + 64 * (j))
#define XB_TOP      3328
#define XB_TOPGEN   3392
#define XCD_BAR_WORDS 3456
#define XB_SPIN_CAP (1u << 18)

__device__ __forceinline__ unsigned xb_ld(unsigned* p)              { return __hip_atomic_load(p, __ATOMIC_RELAXED, __HIP_MEMORY_SCOPE_AGENT); }
__device__ __forceinline__ unsigned xb_add(unsigned* p, unsigned v) { return __hip_atomic_fetch_add(p, v, __ATOMIC_RELAXED, __HIP_MEMORY_SCOPE_AGENT); }
__device__ __forceinline__ unsigned xb_xcc_id() { return (unsigned)__builtin_amdgcn_s_getreg((3 << 11) | 20) & 0xFu; }
#define XB_SPIN(cond, bar) do { unsigned _sp = 0; while (cond) { __builtin_amdgcn_s_sleep(1); \
    if ((++_sp & 255u) == 0u) { if (xb_ld(&(bar)[XB_TMO])) break; if (_sp > XB_SPIN_CAP) { atomicAdd(&(bar)[XB_TMO], 1u); break; } } } } while (0)

struct XcdBarrier {
    unsigned* bar; unsigned x;
    volatile LAS unsigned* st;
};

__device__ __forceinline__ XcdBarrier xcd_barrier_post(unsigned* bar, volatile LAS unsigned* st) {
    XcdBarrier b; b.bar = bar; b.x = xb_xcc_id(); b.st = st;
    if (threadIdx.x == 0) (void)xb_add(&bar[XB_XCNT(b.x)], 1u);
    return b;
}
__device__ __forceinline__ void xcd_barrier_complete(unsigned* bar, unsigned x, unsigned& nloc, unsigned& nx) {
    const unsigned G = gridDim.x * gridDim.y * gridDim.z;
    unsigned sum, cnt, mine, sp = 0u;
    for (;;) {
        sum = 0u; cnt = 0u; mine = 0u;
#pragma unroll
        for (unsigned j = 0; j < 16; ++j) { const unsigned c = xb_ld(&bar[XB_XCNT(j)]); sum += c; cnt += (c > 0u) ? 1u : 0u; mine = (j == x) ? c : mine; }
        if (sum == G) break;
        __builtin_amdgcn_s_sleep(1);
        if ((++sp & 255u) == 0u) { if (xb_ld(&bar[XB_TMO])) break; if (sp > XB_SPIN_CAP) { atomicAdd(&bar[XB_TMO], 1u); break; } }
    }
    nloc = mine > 0u ? mine : 1u; nx = cnt > 0u ? cnt : 1u;
}

__device__ __forceinline__ void xcd_barrier(const XcdBarrier& b) {
    asm volatile("s_waitcnt vmcnt(0)" ::: "memory");
    __syncthreads();
    if (threadIdx.x == 0) {
        unsigned* bar = b.bar;
        __builtin_amdgcn_s_waitcnt(0);
        unsigned nloc = b.st[0], nx = b.st[1];
        if (nloc == 0u) { xcd_barrier_complete(bar, b.x, nloc, nx); b.st[0] = nloc; b.st[1] = nx; }
        const unsigned old = xb_add(&bar[XB_XSUB(b.x)], 1u);
        const unsigned gen = old / nloc;
        if (old + 1u == (gen + 1u) * nloc) {
            __builtin_amdgcn_fence(__ATOMIC_RELEASE, "agent");
            asm volatile("s_waitcnt vmcnt(0)" ::: "memory");
            const unsigned og = xb_add(&bar[XB_TOP], 1u);
            const unsigned tg = og / nx;
            if (og + 1u == (tg + 1u) * nx) xb_add(&bar[XB_TOPGEN], 1u);
            else XB_SPIN(xb_ld(&bar[XB_TOPGEN]) == tg, bar);
            __builtin_amdgcn_fence(__ATOMIC_ACQUIRE, "agent");
            xb_add(&bar[XB_XGEN(b.x)], 1u);
            asm volatile("s_waitcnt vmcnt(0)" ::: "memory");
        } else {
            XB_SPIN(xb_ld(&bar[XB_XGEN(b.x)]) == gen, bar);
            __builtin_amdgcn_fence(__ATOMIC_ACQUIRE, "agent");
            asm volatile("s_waitcnt vmcnt(0)" ::: "memory");
        }
    }
    __syncthreads();
}

typedef float f32x16 __attribute__((ext_vector_type(16)));
typedef short s16x4 __attribute__((ext_vector_type(4)));
typedef unsigned v2u __attribute__((ext_vector_type(2)));

constexpr int NWAVES = 8;
constexpr int BATCH = 16, SEQ = 2048, DM = 1024, M = BATCH * SEQ;
constexpr int FF = 4096;
constexpr int IN_COLS = 4888, N1 = 5120;
constexpr float EPS = 1e-6f;
constexpr float LOG2E = 1.4426950408889634f;
constexpr float QSCALE = 0.125f * LOG2E;
constexpr float NEGBIG = -1e30f;

__constant__ unsigned char T5B[129] = {0,1,2,3,4,5,6,7,8,9,10,11,12,13,14,15,16,16,16,17,17,18,18,18,19,19,19,20,20,20,20,21,21,21,21,22,22,22,22,22,23,23,23,23,23,23,24,24,24,24,24,24,25,25,25,25,25,25,25,26,26,26,26,26,26,26,26,27,27,27,27,27,27,27,27,27,27,28,28,28,28,28,28,28,28,28,28,29,29,29,29,29,29,29,29,29,29,29,29,30,30,30,30,30,30,30,30,30,30,30,30,30,30,31,31,31,31,31,31,31,31,31,31,31,31,31,31,31,31};

constexpr size_t MiB = 1u << 20;
constexpr size_t WS_CTL = 0, CTL_ZERO_BYTES = 1 * MiB;
constexpr size_t WS_ROWSS = 512 * 1024;
constexpr size_t WS_B1P = 768 * 1024;
constexpr size_t WS_WIN = 2 * MiB, WS_WN = 12 * MiB, WS_WSB = 13 * MiB, WS_WO = 14 * MiB, WS_W1 = 16 * MiB, WS_W2 = 24 * MiB;
constexpr size_t WS_CW1K = 32 * MiB, WS_CW1V = 33 * MiB, WS_CW2K = 34 * MiB, WS_CW2V = 34 * MiB + 65536;
constexpr size_t WS_KC = 35 * MiB, WS_VC = 36 * MiB;
constexpr size_t WS_XN = 40 * MiB;
constexpr size_t WS_QN = 104 * MiB;
constexpr size_t WS_KV = 136 * MiB;
constexpr size_t WS_SB = 184 * MiB;
constexpr size_t WS_GN = 280 * MiB;
constexpr size_t WS_GM = 284 * MiB;
constexpr size_t WS_END = 412 * MiB;
constexpr size_t WS_ONSA = 40 * MiB, WS_OSB = 72 * MiB;
constexpr size_t WS_MIX = 184 * MiB;
constexpr size_t WS_F = 40 * MiB;
constexpr size_t WS_X1B = 348 * MiB;
constexpr size_t KVARR = (size_t)BATCH * 2 * SEQ * 64;
constexpr size_t SBARR = (size_t)BATCH * 8 * SEQ * 64;
constexpr int CW_BAR = 4096;

constexpr int RING_OFF = 0, RING_BYTES = 131072;
constexpr int LDSCTL_OFF = RING_BYTES, MISC_OFF = LDSCTL_OFF + 320;
constexpr int LDS_BYTES = 147456;

#ifndef MK_N_LAUNCHES
#define MK_N_LAUNCHES 1
#endif
constexpr int N_PHASES = 10;
#ifndef REP_CMP
#define REP_CMP 1
#endif
#ifndef REP_NSA
#define REP_NSA 1
#endif
#ifndef REP_SB
#define REP_SB 1
#endif

struct Frame {
    LAS unsigned char* lds;
    volatile LAS unsigned* MISC;
    gu32* ctl;
    int tid, lane, wave;
    int vcu, G;
};

__device__ __forceinline__ float wave_sum(float v) {
#pragma unroll
    for (int o = 1; o < 64; o <<= 1) v += __shfl_xor(v, o);
    return v;
}
__device__ __forceinline__ float bf2f(unsigned short b) { return __builtin_bit_cast(float, (unsigned)b << 16); }
__device__ __forceinline__ float fast_exp2(float x) { return __builtin_amdgcn_exp2f(x); }
__device__ __forceinline__ float fast_sigmoid(float x) { return __builtin_amdgcn_rcpf(1.0f + fast_exp2(-x * LOG2E)); }
typedef float f32x2_t __attribute__((ext_vector_type(2))); typedef __bf16 bf16x2_t __attribute__((ext_vector_type(2)));
__device__ __forceinline__ unsigned cvtpk(float lo, float hi) { f32x2_t v = {lo, hi}; bf16x2_t b = __builtin_convertvector(v, bf16x2_t); return __builtin_bit_cast(unsigned, b); }

__device__ __forceinline__ void transpose_item(const float* W, int K, int ldn, int n0, const float* kscale, bf16* WT, int drow0, LAS float* scr, int kb, int lane) {
    const int k0 = 64 * kb;
    const int c = lane & 7;
    if (n0 < 0) {
#pragma unroll
        for (int j = 0; j < 4; ++j) { const int n = (lane >> 3) + 8 * j; *(GAS v4u*)(WT + (size_t)(drow0 + n) * K + k0 + 8 * c) = (v4u){0u, 0u, 0u, 0u}; }
        return;
    }
#pragma unroll 8
    for (int i = 0; i < 32; ++i) { const int kk = 2 * i + (lane >> 5); float v = W[(size_t)(k0 + kk) * ldn + n0 + (lane & 31)]; if (kscale) v *= kscale[k0 + kk]; scr[kk * 33 + (lane & 31)] = v; }
    LDS_WAIT(); asm volatile("" ::: "memory");
#pragma unroll
    for (int j = 0; j < 4; ++j) { const int n = (lane >> 3) + 8 * j; const LAS float* s = scr + (8 * c) * 33 + n;
        v4u o; o.x = pk2(s[0 * 33], s[1 * 33]); o.y = pk2(s[2 * 33], s[3 * 33]); o.z = pk2(s[4 * 33], s[5 * 33]); o.w = pk2(s[6 * 33], s[7 * 33]);
        *(GAS v4u*)(WT + (size_t)(drow0 + n) * K + k0 + 8 * c) = o; }
    LDS_WAIT(); asm volatile("" ::: "memory");
}
__device__ __forceinline__ void rms_row_to_bf16(int lane, const float* xrow, const float* g, bf16* orow) {
    const GAS f32x4* xr = (const GAS f32x4*)xrow + lane; const GAS f32x4* gr = (const GAS f32x4*)g + lane;
    f32x4 v[4]; float s = 0.f;
#pragma unroll
    for (int j = 0; j < 4; ++j) { v[j] = xr[64 * j]; s += (v[j].x * v[j].x + v[j].y * v[j].y) + (v[j].z * v[j].z + v[j].w * v[j].w); }
    const float rstd = 1.f / sqrtf(wave_sum(s) * (1.f / DM) + EPS);
    GAS unsigned long long* o8 = (GAS unsigned long long*)orow + lane;
#pragma unroll
    for (int j = 0; j < 4; ++j) { const f32x4 gg = gr[64 * j];
        o8[64 * j] = (unsigned long long)pk2(v[j].x * rstd * gg.x, v[j].y * rstd * gg.y) | ((unsigned long long)pk2(v[j].z * rstd * gg.z, v[j].w * rstd * gg.w) << 32); }
}
struct In { const float* p[19]; };
__device__ __forceinline__ void p0_prologue(Frame& F, const In& in, unsigned char* ws) {
    LAS float* scr = (LAS float*)(F.lds + RING_OFF + F.wave * 16384);
    const int gw = F.vcu * NWAVES + F.wave, NGW = F.G * NWAVES;
    constexpr int I_IN = 16 * 160, I_UP = 8 * 32, I_O = 16 * 32, I_1 = 16 * 128, I_2 = 64 * 32, I_C1 = 32 * 8, I_C2 = 4 * 2;
    constexpr int NITEMS = I_IN + 2 * I_UP + I_O + I_1 + I_2 + 2 * I_C1 + 2 * I_C2;
    for (int it = gw; it < NITEMS; it += NGW) {
        int r = it;
        if (r < I_IN) { const int kb = r / 160, nb = r % 160; const int d0 = nb * 32;
            const int n0 = d0 < 1280 ? d0 : (d0 < 4864 ? d0 + 24 : (d0 == 4864 ? 1280 : -1));
            transpose_item(in.p[2], 1024, IN_COLS, n0, nullptr, (bf16*)(ws + WS_WIN), d0, scr, kb, F.lane); continue; } r -= I_IN;
        if (r < I_UP) { transpose_item(in.p[12], 512, 1024, (r % 32) * 32, nullptr, (bf16*)(ws + WS_WN), (r % 32) * 32, scr, r / 32, F.lane); continue; } r -= I_UP;
        if (r < I_UP) { transpose_item(in.p[13], 512, 1024, (r % 32) * 32, nullptr, (bf16*)(ws + WS_WSB), (r % 32) * 32, scr, r / 32, F.lane); continue; } r -= I_UP;
        if (r < I_O) { transpose_item(in.p[14], 1024, 1024, (r % 32) * 32, nullptr, (bf16*)(ws + WS_WO), (r % 32) * 32, scr, r / 32, F.lane); continue; } r -= I_O;
        if (r < I_1) { transpose_item(in.p[16], 1024, 4096, (r % 128) * 32, in.p[15], (bf16*)(ws + WS_W1), (r % 128) * 32, scr, r / 128, F.lane); continue; } r -= I_1;
        if (r < I_2) { transpose_item(in.p[17], 4096, 1024, (r % 32) * 32, nullptr, (bf16*)(ws + WS_W2), (r % 32) * 32, scr, r / 32, F.lane); continue; } r -= I_2;
        if (r < I_C1) { transpose_item(in.p[5], 2048, 256, (r % 8) * 32, nullptr, (bf16*)(ws + WS_CW1K), (r % 8) * 32, scr, r / 8, F.lane); continue; } r -= I_C1;
        if (r < I_C1) { transpose_item(in.p[9], 2048, 256, (r % 8) * 32, nullptr, (bf16*)(ws + WS_CW1V), (r % 8) * 32, scr, r / 8, F.lane); continue; } r -= I_C1;
        if (r < I_C2) { transpose_item(in.p[7], 256, 64, (r % 2) * 32, nullptr, (bf16*)(ws + WS_CW2K), (r % 2) * 32, scr, r / 2, F.lane); continue; } r -= I_C2;
        transpose_item(in.p[11], 256, 64, (r % 2) * 32, nullptr, (bf16*)(ws + WS_CW2V), (r % 2) * 32, scr, r / 2, F.lane);
    }
    if (gw < 256) {
        const int kvm = gw >> 7, chunk = (gw >> 2) & 31, nq = gw & 3, n = 64 * nq + F.lane;
        const float* pe = in.p[kvm ? 8 : 4]; const float* w1 = in.p[kvm ? 9 : 5];
        float sum = 0.f;
#pragma unroll 16
        for (int kk = 0; kk < 64; ++kk) sum += pe[64 * chunk + kk] * w1[(size_t)(64 * chunk + kk) * 256 + n];
        atomicAdd((float*)(ws + WS_B1P) + kvm * 256 + n, sum);
    }
    bf16* XN = (bf16*)(ws + WS_XN);
    for (int m = gw; m < M; m += NGW) rms_row_to_bf16(F.lane, in.p[0] + (size_t)m * DM, in.p[1], XN + (size_t)m * DM);
}

__device__ __forceinline__ v4u pack8(const f32x4 a, const f32x4 b) { v4u w; w.x = cvtpk(a[0], a[1]); w.y = cvtpk(a[2], a[3]); w.z = cvtpk(b[0], b[1]); w.w = cvtpk(b[2], b[3]); return w; }
__device__ __forceinline__ f32x4 sig4(const f32x4 a) { f32x4 r; r[0] = fast_sigmoid(a[0]); r[1] = fast_sigmoid(a[1]); r[2] = fast_sigmoid(a[2]); r[3] = fast_sigmoid(a[3]); return r; }

struct EpiInProj {
    static constexpr bool PERM = true, AFTER_DRAIN = false;
    bf16 *QN, *KV, *SB, *GM; float* GN;
    __device__ __forceinline__ void operator()(const f32x4 (&acc)[2][2][4][2], const pg8::Unit& u, int wr, int wc, int fr, int fq) const {
        const int row0 = u.pm * 256 + wr * 64 + fr;
#pragma unroll
        for (int bj = 0; bj < 2; ++bj) {
            const int cb = u.pn * 256 + bj * 128;
            const int c = cb + wc * 32 + 8 * fq;
#pragma unroll
            for (int ai = 0; ai < 2; ++ai)
#pragma unroll
                for (int m = 0; m < 4; ++m) {
                    const int row = row0 + ai * 128 + m * 16; const int b = row >> 11, t = row & 2047;
                    f32x4 v0 = acc[ai][bj][m][0], v1 = acc[ai][bj][m][1];
                    if (cb < 512) { v0 = v0 * QSCALE; v1 = v1 * QSCALE; *(GAS v4u*)(QN + (size_t)row * 512 + c) = pack8(v0, v1); }
                    else if (cb < 1280) { const int cc = c - 512, a = cc >> 7, g = (cc >> 6) & 1, d = cc & 63;
                        *(GAS v4u*)(KV + ((((size_t)a * BATCH + b) * 2 + g) * SEQ + t) * 64 + d) = pack8(v0, v1); }
                    else if (cb < 2816) { const int cc = c - 1280, wh = cc >> 9, h = (cc >> 6) & 7, d = cc & 63;
                        if (wh == 0) { v0 = v0 * QSCALE; v1 = v1 * QSCALE; }
                        *(GAS v4u*)(SB + ((((size_t)wh * BATCH + b) * 8 + h) * SEQ + t) * 64 + d) = pack8(v0, v1); }
                    else if (cb < 4864) { *(GAS v4u*)(GM + (size_t)row * 2048 + (c - 2816)) = pack8(sig4(v0), sig4(v1)); }
                    else { const int cc = c - 4864; if (cc < 24) { GAS f32x4* o = (GAS f32x4*)(GN + (size_t)row * 24 + cc); o[0] = sig4(v0); o[1] = sig4(v1); } }
                }
        }
    }
};
template <bool SECOND> struct EpiUp {
    static constexpr bool PERM = true, AFTER_DRAIN = false;
    bf16* MIX; const bf16* GMg;
    __device__ __forceinline__ void operator()(const f32x4 (&acc)[2][2][4][2], const pg8::Unit& u, int wr, int wc, int fr, int fq) const {
        const int row0 = u.pm * 256 + wr * 64 + fr;
#pragma unroll
        for (int ai = 0; ai < 2; ++ai)
#pragma unroll
            for (int m = 0; m < 4; ++m) { const int row = row0 + ai * 128 + m * 16;
#pragma unroll
                for (int bj = 0; bj < 2; ++bj) { const int c = u.pn * 256 + bj * 128 + wc * 32 + 8 * fq;
                    const v4u gw = *(const GAS v4u*)(GMg + (size_t)row * 2048 + c);
                    float r[8];
#pragma unroll
                    for (int q = 0; q < 4; ++q) { r[2 * q] = __builtin_bit_cast(float, gw[q] << 16); r[2 * q + 1] = __builtin_bit_cast(float, gw[q] & 0xffff0000u); }
                    f32x4 v0 = acc[ai][bj][m][0], v1 = acc[ai][bj][m][1];
#pragma unroll
                    for (int q = 0; q < 4; ++q) { v0[q] *= r[q]; v1[q] *= r[4 + q]; }
                    GAS v4u* dst = (GAS v4u*)(MIX + (size_t)row * 1024 + c);
                    if (SECOND) { const v4u pw = *dst;
#pragma unroll
                        for (int q = 0; q < 2; ++q) { v0[2 * q] += __builtin_bit_cast(float, pw[q] << 16); v0[2 * q + 1] += __builtin_bit_cast(float, pw[q] & 0xffff0000u);
                                                      v1[2 * q] += __builtin_bit_cast(float, pw[2 + q] << 16); v1[2 * q + 1] += __builtin_bit_cast(float, pw[2 + q] & 0xffff0000u); } }
                    *dst = pack8(v0, v1); } }
    }
};
struct EpiOut {
    static constexpr bool PERM = true, AFTER_DRAIN = false;
    const float* X; float* X1; bf16* X1B; float* rowss;
    __device__ __forceinline__ void operator()(const f32x4 (&acc)[2][2][4][2], const pg8::Unit& u, int wr, int wc, int fr, int fq) const {
        const int row0 = u.pm * 256 + wr * 64 + fr;
#pragma unroll
        for (int ai = 0; ai < 2; ++ai)
#pragma unroll
            for (int m = 0; m < 4; ++m) { const int row = row0 + ai * 128 + m * 16; float ss = 0.f;
#pragma unroll
                for (int bj = 0; bj < 2; ++bj) { const int c = u.pn * 256 + bj * 128 + wc * 32 + 8 * fq; const size_t off = (size_t)row * 1024 + c;
                    const f32x4 x0 = *(const GAS f32x4*)(X + off), x1 = *(const GAS f32x4*)(X + off + 4);
                    const f32x4 y0 = x0 + acc[ai][bj][m][0], y1 = x1 + acc[ai][bj][m][1];
                    *(GAS f32x4*)(X1 + off) = y0; *(GAS f32x4*)(X1 + off + 4) = y1; *(GAS v4u*)(X1B + off) = pack8(y0, y1);
                    ss += (y0[0] * y0[0] + y0[1] * y0[1]) + (y0[2] * y0[2] + y0[3] * y0[3]) + (y1[0] * y1[0] + y1[1] * y1[1]) + (y1[2] * y1[2] + y1[3] * y1[3]); }
                ss += __shfl_xor(ss, 16); ss += __shfl_xor(ss, 32);
                if (fq == 0) atomicAdd(rowss + row, ss); }
    }
};
struct EpiFF1 {
    static constexpr bool PERM = true, AFTER_DRAIN = false;
    bf16* Fo; const float* rowss;
    __device__ __forceinline__ void operator()(const f32x4 (&acc)[2][2][4][2], const pg8::Unit& u, int wr, int wc, int fr, int fq) const {
        const int row0 = u.pm * 256 + wr * 64 + fr;
#pragma unroll
        for (int ai = 0; ai < 2; ++ai)
#pragma unroll
            for (int m = 0; m < 4; ++m) { const int row = row0 + ai * 128 + m * 16;
                const float rs2 = 1.0f / (rowss[row] * (1.0f / DM) + EPS);
#pragma unroll
                for (int bj = 0; bj < 2; ++bj) { const int c = u.pn * 256 + bj * 128 + wc * 32 + 8 * fq;
                    f32x4 v0 = acc[ai][bj][m][0], v1 = acc[ai][bj][m][1];
#pragma unroll
                    for (int q = 0; q < 4; ++q) { const float a = fmaxf(v0[q], 0.f), b = fmaxf(v1[q], 0.f); v0[q] = a * a * rs2; v1[q] = b * b * rs2; }
                    *(GAS v4u*)(Fo + (size_t)row * FF + c) = pack8(v0, v1); } }
    }
};
struct EpiFF2 {
    static constexpr bool PERM = true, AFTER_DRAIN = false;
    float* X1;
    __device__ __forceinline__ void operator()(const f32x4 (&acc)[2][2][4][2], const pg8::Unit& u, int wr, int wc, int fr, int fq) const {
        const int row0 = u.pm * 256 + wr * 64 + fr;
#pragma unroll
        for (int ai = 0; ai < 2; ++ai)
#pragma unroll
            for (int m = 0; m < 4; ++m) { const int row = row0 + ai * 128 + m * 16;
#pragma unroll
                for (int bj = 0; bj < 2; ++bj) { const int c = u.pn * 256 + bj * 128 + wc * 32 + 8 * fq; GAS f32x4* p = (GAS f32x4*)(X1 + (size_t)row * 1024 + c);
                    p[0] = p[0] + acc[ai][bj][m][0]; p[1] = p[1] + acc[ai][bj][m][1]; } }
    }
};

namespace att {
typedef short v4i16_t __attribute__((ext_vector_type(4)));
constexpr int L_K0 = 0, L_K1 = 8192, L_V0 = 16384, L_V1 = 24576, L_TR = 32768, L_EM = 36864, L_TC = 37376, L_WMASK = 39936, L_DONE = 40000;
constexpr float THR = 8.0f;
constexpr int L_CA = 0, L_HID = 69632;
__device__ __forceinline__ int crow(int r, int hi) { return (r & 3) + 8 * (r >> 2) + 4 * hi; }
__device__ __forceinline__ s16x4 vtr(const LAS unsigned char* p) { return __builtin_bit_cast(s16x4, __builtin_amdgcn_ds_read_tr16_b64_v4i16((LAS v4i16_t*)p)); }
__device__ __forceinline__ float swapmax(float v) { auto rr = __builtin_amdgcn_permlane32_swap(__float_as_uint(v), __float_as_uint(v), false, false); return fmaxf(__uint_as_float(rr[0]), __uint_as_float(rr[1])); }
__device__ __forceinline__ float swapsum(float v) { auto rr = __builtin_amdgcn_permlane32_swap(__float_as_uint(v), __float_as_uint(v), false, false); return __uint_as_float(rr[0]) + __uint_as_float(rr[1]); }

__device__ __forceinline__ v4u ld_piece(const bf16* g, int tid) { return *(const GAS v4u*)((const GAS char*)g + tid * 16); }
__device__ __forceinline__ void st_kimg(LAS unsigned char* K, int tid, v4u v) { const int key = tid >> 3, ch = tid & 7; *(LAS v4u*)(K + ch * 1024 + key * 16) = v; }
__device__ __forceinline__ void st_vimg(LAS unsigned char* V, int tid, v4u v) { const int key = tid >> 3, c8 = tid & 7; *(LAS v4u*)(V + ((c8 >> 2) * 4 + (key >> 4)) * 1024 + (key & 15) * 64 + (c8 & 3) * 16) = v; }

__device__ __forceinline__ void qkt(f32x16& p0, f32x16& p1, const LAS unsigned char* Kimg, const bf16x8 (&qr)[4], int r32, int hi) {
    const LAS unsigned char* kb = Kimg + hi * 1024 + r32 * 16;
    f32x16 a = {}, b = {};
#pragma unroll
    for (int d0 = 0; d0 < 4; ++d0) {
        const bf16x8 k0 = *(const LAS bf16x8*)(kb + d0 * 2048);
        const bf16x8 k1 = *(const LAS bf16x8*)(kb + d0 * 2048 + 512);
        a = __builtin_amdgcn_mfma_f32_32x32x16_bf16(k0, qr[d0], a, 0, 0, 0);
        b = __builtin_amdgcn_mfma_f32_32x32x16_bf16(k1, qr[d0], b, 0, 0, 0);
    }
    p0 = a; p1 = b;
}
__device__ __forceinline__ void pv(f32x16 (&o)[2], const LAS unsigned char* Vimg, int lane, const f32x16& p0, const f32x16& p1) {
    const int hi = lane >> 5;
    const LAS unsigned char* vb = Vimg + ((lane >> 4) & 1) * 32 + (lane & 3) * 8 + (4 * hi + ((lane & 15) >> 2)) * 64;
    bf16x8 pa[4];
    { v4u w;
      w.x = cvtpk(p0[0], p0[1]); w.y = cvtpk(p0[2], p0[3]); w.z = cvtpk(p0[4], p0[5]); w.w = cvtpk(p0[6], p0[7]); pa[0] = __builtin_bit_cast(bf16x8, w);
      w.x = cvtpk(p0[8], p0[9]); w.y = cvtpk(p0[10], p0[11]); w.z = cvtpk(p0[12], p0[13]); w.w = cvtpk(p0[14], p0[15]); pa[1] = __builtin_bit_cast(bf16x8, w);
      w.x = cvtpk(p1[0], p1[1]); w.y = cvtpk(p1[2], p1[3]); w.z = cvtpk(p1[4], p1[5]); w.w = cvtpk(p1[6], p1[7]); pa[2] = __builtin_bit_cast(bf16x8, w);
      w.x = cvtpk(p1[8], p1[9]); w.y = cvtpk(p1[10], p1[11]); w.z = cvtpk(p1[12], p1[13]); w.w = cvtpk(p1[14], p1[15]); pa[3] = __builtin_bit_cast(bf16x8, w); }
#pragma unroll
    for (int dh = 0; dh < 2; ++dh)
#pragma unroll
        for (int ks = 0; ks < 4; ++ks) {
            const s16x4 lo = vtr(vb + dh * 4096 + ks * 1024), hh = vtr(vb + dh * 4096 + ks * 1024 + 512);
            const bf16x8 vf = (bf16x8){lo[0], lo[1], lo[2], lo[3], hh[0], hh[1], hh[2], hh[3]};
            o[dh] = __builtin_amdgcn_mfma_f32_32x32x16_bf16(vf, pa[ks], o[dh], 0, 0, 0);
        }
}
__device__ __forceinline__ float max3f(float a, float b, float c) { float r; asm("v_max3_f32 %0, %1, %2, %3" : "=v"(r) : "v"(a), "v"(b), "v"(c)); return r; }
__device__ __forceinline__ float max2f(float a, float b) { float r; asm("v_max_f32_e32 %0, %1, %2" : "=v"(r) : "v"(a), "v"(b)); return r; }
__device__ __forceinline__ void qkt_c(f32x16& p0, f32x16& p1, const LAS unsigned char* Kimg, const bf16x8 (&qr)[4], int r32, int hi, const f32x16& c) {
    const LAS unsigned char* kb = Kimg + hi * 1024 + r32 * 16;
    f32x16 a = c, b = c;
#pragma unroll
    for (int d0 = 0; d0 < 4; ++d0) {
        const bf16x8 k0 = *(const LAS bf16x8*)(kb + d0 * 2048);
        const bf16x8 k1 = *(const LAS bf16x8*)(kb + d0 * 2048 + 512);
        a = __builtin_amdgcn_mfma_f32_32x32x16_bf16(k0, qr[d0], a, 0, 0, 0);
        b = __builtin_amdgcn_mfma_f32_32x32x16_bf16(k1, qr[d0], b, 0, 0, 0);
    }
    p0 = a; p1 = b;
}
__device__ __forceinline__ void pv_m(f32x16 (&o)[2], const LAS unsigned char* Vimg, int lane, const f32x16& p0, const f32x16& p1, unsigned amask) {
    const int hi = lane >> 5;
    const LAS unsigned char* vb = Vimg + ((lane >> 4) & 1) * 32 + (lane & 3) * 8 + (4 * hi + ((lane & 15) >> 2)) * 64;
    bf16x8 pa[4];
    { v4u w;
      w.x = cvtpk(p0[0], p0[1]) & amask; w.y = cvtpk(p0[2], p0[3]) & amask; w.z = cvtpk(p0[4], p0[5]) & amask; w.w = cvtpk(p0[6], p0[7]) & amask; pa[0] = __builtin_bit_cast(bf16x8, w);
      w.x = cvtpk(p0[8], p0[9]) & amask; w.y = cvtpk(p0[10], p0[11]) & amask; w.z = cvtpk(p0[12], p0[13]) & amask; w.w = cvtpk(p0[14], p0[15]) & amask; pa[1] = __builtin_bit_cast(bf16x8, w);
      w.x = cvtpk(p1[0], p1[1]) & amask; w.y = cvtpk(p1[2], p1[3]) & amask; w.z = cvtpk(p1[4], p1[5]) & amask; w.w = cvtpk(p1[6], p1[7]) & amask; pa[2] = __builtin_bit_cast(bf16x8, w);
      w.x = cvtpk(p1[8], p1[9]) & amask; w.y = cvtpk(p1[10], p1[11]) & amask; w.z = cvtpk(p1[12], p1[13]) & amask; w.w = cvtpk(p1[14], p1[15]) & amask; pa[3] = __builtin_bit_cast(bf16x8, w); }
#pragma unroll
    for (int dh = 0; dh < 2; ++dh)
#pragma unroll
        for (int ks = 0; ks < 4; ++ks) {
            const s16x4 lo = vtr(vb + dh * 4096 + ks * 1024), hh = vtr(vb + dh * 4096 + ks * 1024 + 512);
            const bf16x8 vf = (bf16x8){lo[0], lo[1], lo[2], lo[3], hh[0], hh[1], hh[2], hh[3]};
            o[dh] = __builtin_amdgcn_mfma_f32_32x32x16_bf16(vf, pa[ks], o[dh], 0, 0, 0);
        }
}
struct SM {
    float mref, l; bool started; f32x16 negm; f32x16 o[2];
    __device__ __forceinline__ void reset() { mref = 0.f; l = 0.f; started = false; negm = f32x16{}; o[0] = f32x16{}; o[1] = f32x16{}; }
};
template <int BIAS>
__device__ __forceinline__ void sm_tile(SM& S, const LAS unsigned char* Kimg, const LAS unsigned char* Vimg, const bf16x8 (&qr)[4], int lane, const LAS float* tb, bool active) {
    const int r32 = lane & 31, hi = lane >> 5;
    f32x16 p0, p1; qkt_c(p0, p1, Kimg, qr, r32, hi, S.negm);
    if (BIAS) {
#pragma unroll
        for (int r = 0; r < 16; ++r) { p0[r] += tb[(r & 3) + 8 * (r >> 2)]; p1[r] += tb[32 + (r & 3) + 8 * (r >> 2)]; }
    } else asm volatile("s_nop 15\n\ts_nop 7" : "+v"(p0), "+v"(p1));
    float a = max3f(p0[0], p0[1], p1[0]), b = max3f(p0[2], p0[3], p1[1]); a = max3f(a, p1[2], p1[3]);
#pragma unroll
    for (int r = 4; r < 16; r += 4) { a = max3f(a, p0[r], p0[r + 1]); b = max3f(b, p0[r + 2], p0[r + 3]); a = max3f(a, p1[r], p1[r + 1]); b = max3f(b, p1[r + 2], p1[r + 3]); }
    float rm = swapmax(max2f(a, b));
    if (!active) rm = NEGBIG;
    const bool need = S.started ? (rm > THR) : (rm > -1e29f);
    if (__any(need)) {
        const float dl = need ? rm : 0.f;
        const float f = S.started ? fast_exp2(-dl) : 1.0f;
        S.mref += dl; S.started = S.started || need; S.l *= f;
#pragma unroll
        for (int r = 0; r < 16; ++r) { p0[r] -= dl; p1[r] -= dl; S.o[0][r] *= f; S.o[1][r] *= f; S.negm[r] = -S.mref; }
    }
    float s = 0.f;
#pragma unroll
    for (int r = 0; r < 16; ++r) { p0[r] = fast_exp2(p0[r]); p1[r] = fast_exp2(p1[r]); s += p0[r] + p1[r]; }
    S.l += active ? s : 0.f;
    pv_m(S.o, Vimg, lane, p0, p1, active ? 0xffffffffu : 0u);
}
__device__ __forceinline__ void acc_out(f32x16 (&oacc)[2], const f32x16 (&o)[2], float sc) {
#pragma unroll
    for (int r = 0; r < 16; ++r) { oacc[0][r] += o[0][r] * sc; oacc[1][r] += o[1][r] * sc; }
}
__device__ __forceinline__ void store_o(bf16* dst, const f32x16 (&o)[2], int hi) {
#pragma unroll
    for (int dh = 0; dh < 2; ++dh)
#pragma unroll
        for (int i = 0; i < 4; ++i) { v2u w; w.x = cvtpk(o[dh][4 * i], o[dh][4 * i + 1]); w.y = cvtpk(o[dh][4 * i + 2], o[dh][4 * i + 3]);
            *(GAS v2u*)(dst + 32 * dh + 8 * i + 4 * hi) = w; }
}
struct TileIter {
    unsigned um; int j, jt0, kind, n;
    __device__ __forceinline__ void init(unsigned um_, int j_) { um = um_; j = j_; jt0 = j_ >= 8 ? j_ - 8 : 0; kind = 0; n = -1; }
    __device__ __forceinline__ bool advance() {
        if (kind == 0) { const unsigned rest = (n >= 31) ? 0u : ((um >> (n + 1)) << (n + 1));
            if (rest) { n = __builtin_ctz(rest); return true; }
            kind = 1; n = jt0; return true; }
        ++n; return n <= j;
    }
};

__device__ __forceinline__ void nsa_unit(Frame& F, unsigned char* ws, const float* rel_bias, int b, int g, int j) {
    LAS unsigned char* lds = F.lds;
    int tid = F.tid; asm volatile("" : "+v"(tid));
    const int lane = tid & 63, w = F.wave, r32 = lane & 31, hi = lane >> 5;
    const int tl = r32 >> 2, hd = r32 & 3, tokl = 8 * w + tl, t = 64 * j + tokl, head = 4 * g + hd;
    const size_t row = (size_t)b * SEQ + t;
    const bf16* QN = (const bf16*)(ws + WS_QN); const bf16* KV = (const bf16*)(ws + WS_KV); const float* GN = (const float*)(ws + WS_GN);
    LAS float* TR = (LAS float*)(lds + L_TR); LAS float* EM = (LAS float*)(lds + L_EM); LAS float* TC = (LAS float*)(lds + L_TC); LAS unsigned* wmask = (LAS unsigned*)(lds + L_WMASK);
    const bool two = j >= 16;
    __syncthreads();
    for (int i = tid; i < 4 * 256; i += 512) { const int h = i >> 8, dist = 191 - (i & 255);
        TR[i] = dist < 0 ? NEGBIG : (dist < 128 ? (rel_bias[T5B[dist] * 8 + 4 * g + h] - rel_bias[31 * 8 + 4 * g + h]) * LOG2E : 0.f); }
    if (tid < 128) EM[tid] = tid > 63 ? 0.f : NEGBIG;
    for (int i = tid; i < 4 * 129; i += 512) { const int h = i / 129, d = i % 129; TC[h * 132 + d] = (rel_bias[T5B[d] * 8 + 4 * g + h] - rel_bias[31 * 8 + 4 * g + h]) * LOG2E; }
    { const bf16* kc = (const bf16*)(ws + WS_KC) + (size_t)(b * 2 + g) * 128 * 64; const bf16* vc = (const bf16*)(ws + WS_VC) + (size_t)(b * 2 + g) * 128 * 64;
      const v4u a0 = ld_piece(kc, tid), c0 = ld_piece(vc, tid); st_kimg(lds + L_K0, tid, a0); st_vimg(lds + L_V0, tid, c0);
      if (two) { const v4u a1 = ld_piece(kc + 4096, tid), c1 = ld_piece(vc + 4096, tid); st_kimg(lds + L_K1, tid, a1); st_vimg(lds + L_V1, tid, c1); } }
    bf16x8 qr[4];
    { const bf16* qp = QN + row * 512 + head * 64;
#pragma unroll
      for (int d0 = 0; d0 < 4; ++d0) qr[d0] = *(const GAS bf16x8*)(qp + 16 * d0 + 8 * hi); }
    const float g_cmp = GN[row * 24 + head * 3 + 0], g_sel = GN[row * 24 + head * 3 + 1], g_win = GN[row * 24 + head * 3 + 2];
    __syncthreads();
    f32x16 oacc[2]; oacc[0] = f32x16{}; oacc[1] = f32x16{};
    unsigned mymask = 1u | (1u << j);
    {
        f32x16 s[4];
        qkt(s[0], s[1], lds + L_K0, qr, r32, hi);
        if (two) qkt(s[2], s[3], lds + L_K1, qr, r32, hi); else { s[2] = f32x16{}; s[3] = f32x16{}; }
        const LAS float* tc = TC + hd * 132;
        const int dbase = t - 31 - 64 * hi;
        float mx = NEGBIG;
#pragma unroll
        for (int q = 0; q < 4; ++q) {
            if (32 * q + 31 <= 4 * j - 10) {
#pragma unroll
                for (int r = 0; r < 16; ++r) mx = fmaxf(mx, s[q][r]);
            } else if (32 * q > 4 * j + 2) {
#pragma unroll
                for (int r = 0; r < 16; ++r) s[q][r] = NEGBIG;
            } else {
#pragma unroll
                for (int r = 0; r < 16; ++r) { const int dist = dbase - 16 * (32 * q + (r & 3) + 8 * (r >> 2));
                    const int di = dist < 0 ? 0 : (dist > 128 ? 128 : dist);
                    const float v = dist >= 0 ? s[q][r] + tc[di] : NEGBIG; s[q][r] = v; mx = fmaxf(mx, v); }
            }
        }
        mx = swapmax(mx);
        const bool anyv = mx > -1e29f;
        const float sub = anyv ? mx : 1e30f;
        float sum = 0.f;
#pragma unroll
        for (int q = 0; q < 4; ++q)
#pragma unroll
            for (int r = 0; r < 16; ++r) { const float p = fast_exp2(s[q][r] - sub); s[q][r] = p; sum += p; }
        sum = swapsum(sum);
        const float inv = anyv ? 1.0f / sum : 0.f;
#pragma unroll
        for (int q = 0; q < 4; ++q)
#pragma unroll
            for (int r = 0; r < 16; ++r) s[q][r] *= inv;
        float val[16];
#pragma unroll
        for (int q = 0; q < 4; ++q)
#pragma unroll
            for (int i = 0; i < 4; ++i) val[4 * q + i] = (s[q][4 * i] + s[q][4 * i + 1]) + (s[q][4 * i + 2] + s[q][4 * i + 3]);
#pragma unroll
        for (int u = 0; u < 16; ++u) {
            const float lastu = s[u >> 2][4 * (u & 3) + 3];
            auto rr = __builtin_amdgcn_permlane32_swap(__float_as_uint(lastu), __float_as_uint(lastu), false, false);
            if (hi) val[u] += __uint_as_float(rr[0]); else if (u + 1 < 16) val[u + 1] += __uint_as_float(rr[1]);
        }
#pragma unroll
        for (int u = 0; u < 16; ++u) { val[u] += __shfl_xor(val[u], 1); val[u] += __shfl_xor(val[u], 2); }
        {
            unsigned b1 = 0u, b2 = 0u;
#pragma unroll
            for (int u = 0; u < 16; ++u) { const int n = 2 * u + hi; const unsigned key = (n >= 1 && n < j) ? ((__float_as_uint(val[u]) & ~31u) | (unsigned)(31 - n)) : 0u;
                const unsigned lo = b1 < key ? b1 : key; b1 = b1 < key ? key : b1; b2 = b2 < lo ? lo : b2; }
            auto ra = __builtin_amdgcn_permlane32_swap(b1, b1, false, false); auto rb = __builtin_amdgcn_permlane32_swap(b2, b2, false, false);
            const unsigned a1 = ra[0], c1 = ra[1], a2 = rb[0], c2 = rb[1];
            const unsigned t1 = a1 > c1 ? a1 : c1, lo1 = a1 > c1 ? c1 : a1, hi2 = a2 > c2 ? a2 : c2, t2 = lo1 > hi2 ? lo1 : hi2;
            if (t1) mymask |= 1u << (31 - (t1 & 31u));
            if (t2) mymask |= 1u << (31 - (t2 & 31u));
        }
        f32x16 o[2]; o[0] = f32x16{}; o[1] = f32x16{};
        pv(o, lds + L_V0, lane, s[0], s[1]);
        if (two) pv(o, lds + L_V1, lane, s[2], s[3]);
        acc_out(oacc, o, g_cmp);
    }
    unsigned wm = mymask;
#pragma unroll
    for (int o_ = 1; o_ < 64; o_ <<= 1) wm |= (unsigned)__shfl_xor((int)wm, o_);
    if (lane == 0) wmask[w] = wm;
    __syncthreads();
    unsigned um = 0;
#pragma unroll
    for (int i = 0; i < 8; ++i) um |= wmask[i];
    um = (unsigned)__builtin_amdgcn_readfirstlane((int)um);
    wm = (unsigned)__builtin_amdgcn_readfirstlane((int)wm);
    {
        const size_t slab = (size_t)(b * 2 + g) * SEQ * 64;
        const bf16* ks = KV + 2 * KVARR + slab; const bf16* vs = KV + 3 * KVARR + slab; const bf16* kw = KV + 4 * KVARR + slab; const bf16* vw = KV + 5 * KVARR + slab;
        SM S; S.reset();
        const LAS float* trb = TR + hd * 256 + 191 - (tokl - 4 * hi);
        const LAS float* emb = EM + 63 - (tokl - 4 * hi);
        TileIter cur; cur.init(um, j); cur.advance();
        v4u ka = ld_piece((cur.kind ? kw : ks) + (size_t)cur.n * 4096, tid), va = ld_piece((cur.kind ? vw : vs) + (size_t)cur.n * 4096, tid);
        int buf = 0; bool more = true;
        while (more) {
            LAS unsigned char* Kb = lds + (buf ? L_K1 : L_K0); LAS unsigned char* Vb = lds + (buf ? L_V1 : L_V0);
            st_kimg(Kb, tid, ka); st_vimg(Vb, tid, va);
            TileIter nxt = cur; more = nxt.advance();
            if (more) { ka = ld_piece((nxt.kind ? kw : ks) + (size_t)nxt.n * 4096, tid); va = ld_piece((nxt.kind ? vw : vs) + (size_t)nxt.n * 4096, tid); }
            __syncthreads();
            const int n = cur.n, dj = j - n;
            if (cur.kind == 0) {
                if ((wm >> n) & 1u) {
                    const bool sel = (mymask >> n) & 1u;
                    if (dj >= 3) sm_tile<0>(S, Kb, Vb, qr, lane, trb, sel);
                    else sm_tile<1>(S, Kb, Vb, qr, lane, trb - 64 * dj, sel);
                }
                if (nxt.kind == 1) {
                    const float l = swapsum(S.l); acc_out(oacc, S.o, g_sel / l);
                    S.reset();
                }
            } else {
                if (dj >= 3 && dj < 8) sm_tile<0>(S, Kb, Vb, qr, lane, trb, true);
                else if (dj == 8) sm_tile<1>(S, Kb, Vb, qr, lane, emb, true);
                else sm_tile<1>(S, Kb, Vb, qr, lane, trb - 64 * dj, true);
            }
            cur = nxt; buf ^= 1;
        }
        const float l = swapsum(S.l);
        acc_out(oacc, S.o, g_win / l);
    }
    store_o((bf16*)(ws + WS_ONSA) + row * 512 + head * 64, oacc, hi);
}

__device__ __forceinline__ void sb_unit(Frame& F, unsigned char* ws, int b, int h, int qb) {
    LAS unsigned char* lds = F.lds;
    int tid = F.tid; asm volatile("" : "+v"(tid));
    const int lane = tid & 63, w = F.wave, r32 = lane & 31, hi = lane >> 5;
    const int t = 256 * qb + 32 * w + r32;
    const bf16* SBQ = (const bf16*)(ws + WS_SB) + (size_t)(b * 8 + h) * SEQ * 64; const bf16* SBK = SBQ + SBARR; const bf16* SBV = SBQ + 2 * SBARR;
    LAS unsigned* donef = (LAS unsigned*)(lds + L_DONE);
    bf16x8 qr[4];
#pragma unroll
    for (int d0 = 0; d0 < 4; ++d0) qr[d0] = *(const GAS bf16x8*)(SBQ + (size_t)t * 64 + 16 * d0 + 8 * hi);
    f32x16 o[2]; o[0] = f32x16{}; o[1] = f32x16{};
    float C = 0.f;
    bool done = false;
    const int ktop = 4 * qb + 3, kmine = 4 * qb + (w >> 1);
    __syncthreads();
    v4u ka = ld_piece(SBK + (size_t)ktop * 4096, tid), va = ld_piece(SBV + (size_t)ktop * 4096, tid);
    int buf = 0;
    for (int kt = ktop; kt >= 0; --kt) {
        LAS unsigned char* Kb = lds + (buf ? L_K1 : L_K0); LAS unsigned char* Vb = lds + (buf ? L_V1 : L_V0);
        st_kimg(Kb, tid, ka); st_vimg(Vb, tid, va);
        if (lane == 0) donef[buf * 8 + w] = done ? 1u : 0u;
        if (kt > 0) { ka = ld_piece(SBK + (size_t)(kt - 1) * 4096, tid); va = ld_piece(SBV + (size_t)(kt - 1) * 4096, tid); }
        __syncthreads();
        unsigned nd = 0;
#pragma unroll
        for (int i = 0; i < 8; ++i) nd += donef[buf * 8 + i];
        buf ^= 1;
        if (__builtin_amdgcn_readfirstlane((int)nd) == 8) break;
        if (done || kt > kmine) continue;
        f32x16 z0, z1; qkt(z0, z1, Kb, qr, r32, hi);
        const int kb0 = 64 * kt + 4 * hi;
        f32x16 lb0, lb1;
        if (kt == kmine) {
#pragma unroll
            for (int r = 0; r < 16; ++r) {
                { const float z = z0[r], e = fast_exp2(-fabsf(z)), L = __builtin_amdgcn_logf(1.0f + e); const bool ok = kb0 + (r & 3) + 8 * (r >> 2) < t;
                  lb0[r] = ok ? fminf(z, 0.f) - L : NEGBIG; z0[r] = ok ? -fmaxf(z, 0.f) - L : 0.f; }
                { const float z = z1[r], e = fast_exp2(-fabsf(z)), L = __builtin_amdgcn_logf(1.0f + e); const bool ok = kb0 + 32 + (r & 3) + 8 * (r >> 2) < t;
                  lb1[r] = ok ? fminf(z, 0.f) - L : NEGBIG; z1[r] = ok ? -fmaxf(z, 0.f) - L : 0.f; }
            }
        } else {
#pragma unroll
            for (int r = 0; r < 16; ++r) {
                { const float z = z0[r], e = fast_exp2(-fabsf(z)), L = __builtin_amdgcn_logf(1.0f + e); lb0[r] = fminf(z, 0.f) - L; z0[r] = -fmaxf(z, 0.f) - L; }
                { const float z = z1[r], e = fast_exp2(-fabsf(z)), L = __builtin_amdgcn_logf(1.0f + e); lb1[r] = fminf(z, 0.f) - L; z1[r] = -fmaxf(z, 0.f) - L; }
            }
        }
        float gs[8];
#pragma unroll
        for (int i = 0; i < 4; ++i) { gs[i] = (z0[4 * i] + z0[4 * i + 1]) + (z0[4 * i + 2] + z0[4 * i + 3]); gs[4 + i] = (z1[4 * i] + z1[4 * i + 1]) + (z1[4 * i + 2] + z1[4 * i + 3]); }
        float E[8]; float run = 0.f;
#pragma unroll
        for (int u = 7; u >= 0; --u) {
            auto rr = __builtin_amdgcn_permlane32_swap(__float_as_uint(gs[u]), __float_as_uint(gs[u]), false, false);
            const float g0 = __uint_as_float(rr[0]), g1 = __uint_as_float(rr[1]);
            const float e1 = run; run += g1; const float e0 = run; run += g0;
            E[u] = hi ? e1 : e0;
        }
#pragma unroll
        for (int i = 0; i < 4; ++i) {
            { float later = C + E[i];
              const float a3 = fast_exp2(lb0[4 * i + 3] + later); later += z0[4 * i + 3];
              const float a2 = fast_exp2(lb0[4 * i + 2] + later); later += z0[4 * i + 2];
              const float a1 = fast_exp2(lb0[4 * i + 1] + later); later += z0[4 * i + 1];
              const float a0 = fast_exp2(lb0[4 * i] + later);
              z0[4 * i] = a0; z0[4 * i + 1] = a1; z0[4 * i + 2] = a2; z0[4 * i + 3] = a3; }
            { float later = C + E[4 + i];
              const float a3 = fast_exp2(lb1[4 * i + 3] + later); later += z1[4 * i + 3];
              const float a2 = fast_exp2(lb1[4 * i + 2] + later); later += z1[4 * i + 2];
              const float a1 = fast_exp2(lb1[4 * i + 1] + later); later += z1[4 * i + 1];
              const float a0 = fast_exp2(lb1[4 * i] + later);
              z1[4 * i] = a0; z1[4 * i + 1] = a1; z1[4 * i + 2] = a2; z1[4 * i + 3] = a3; }
        }
        C += run;
        pv(o, Vb, lane, z0, z1);
        done = __all(C < -151.0f);
    }
    store_o((bf16*)(ws + WS_OSB) + ((size_t)b * SEQ + t) * 512 + h * 64, o, hi);
}

__device__ __forceinline__ float gelu_tanh(float x) {
    const float u = 0.7978845608028654f * (x + 0.044715f * x * x * x);
    const float e = fast_exp2(2.0f * LOG2E * u);
    const float th = 1.0f - 2.0f * __builtin_amdgcn_rcpf(e + 1.0f);
    return 0.5f * x * (1.0f + th);
}
__device__ __forceinline__ void cmp_unit(Frame& F, unsigned char* ws, const float* b1, int kv, int b, int g, int cc) {
    LAS unsigned char* lds = F.lds;
    int tid = F.tid; asm volatile("" : "+v"(tid));
    const int lane = tid & 63, w = F.wave, r32 = lane & 31, hi = lane >> 5;
    const bf16* src = (const bf16*)(ws + WS_KV) + (size_t)kv * KVARR + (size_t)(b * 2 + g) * SEQ * 64 + (size_t)(512 * cc) * 64;
    const bf16* W1T = (const bf16*)(ws + (kv ? WS_CW1V : WS_CW1K)); const bf16* W2T = (const bf16*)(ws + (kv ? WS_CW2V : WS_CW2K));
    const float* b1p = (const float*)(ws + WS_B1P) + kv * 256;
    bf16* dst = (bf16*)(ws + (kv ? WS_VC : WS_KC)) + (size_t)(b * 2 + g) * 128 * 64;
    LAS bf16* hid = (LAS bf16*)(lds + L_HID);
    __syncthreads();
    for (int p = tid; p < 528 * 8; p += 512) { const int tok = p >> 3, ch = p & 7;
        const v4u v = *(const GAS v4u*)((const GAS char*)src + (size_t)p * 16);
        *(LAS v4u*)(lds + L_CA + tok * 128 + ((ch ^ ((tok >> 4) & 7)) * 16)) = v; }
    __syncthreads();
    f32x16 acc = {};
    const bf16* brow = W1T + (size_t)(32 * w + r32) * 2048 + 8 * hi;
#pragma unroll 4
    for (int ks = 0; ks < 128; ++ks) {
        const int l = ks >> 2, ch = 2 * (ks & 3) + hi, tok = 16 * r32 + l;
        const bf16x8 af = *(const LAS bf16x8*)(lds + L_CA + tok * 128 + ((ch ^ ((tok >> 4) & 7)) * 16));
        const bf16x8 bf = *(const GAS bf16x8*)(brow + 16 * ks);
        acc = __builtin_amdgcn_mfma_f32_32x32x16_bf16(af, bf, acc, 0, 0, 0);
    }
    { const float bias = b1[32 * w + r32] + b1p[32 * w + r32];
#pragma unroll
      for (int r = 0; r < 16; ++r) hid[crow(r, hi) * 264 + 32 * w + r32] = (bf16)f2bf(gelu_tanh(acc[r] + bias)); }
    __syncthreads();
    if (w < 2) {
        f32x16 o = {};
        const LAS bf16* hrow = hid + r32 * 264 + 8 * hi;
        const bf16* w2row = W2T + (size_t)(32 * w + r32) * 256 + 8 * hi;
#pragma unroll
        for (int ks = 0; ks < 16; ++ks) {
            const bf16x8 af = *(const LAS bf16x8*)(hrow + 16 * ks);
            const bf16x8 bf = *(const GAS bf16x8*)(w2row + 16 * ks);
            o = __builtin_amdgcn_mfma_f32_32x32x16_bf16(af, bf, o, 0, 0, 0);
        }
#pragma unroll
        for (int r = 0; r < 16; ++r) { const int cr = 32 * cc + crow(r, hi); dst[(size_t)cr * 64 + 32 * w + r32] = (bf16)(cr < 127 ? f2bf(o[r]) : 0u); }
    }
}
}

__device__ __forceinline__ void final_norm_row(int lane, float* xrow, const float* g) {
    GAS f32x4* xr = (GAS f32x4*)xrow + lane; const GAS f32x4* gr = (const GAS f32x4*)g + lane;
    f32x4 v[4]; float s = 0.f;
#pragma unroll
    for (int j = 0; j < 4; ++j) { v[j] = xr[64 * j]; s += (v[j].x * v[j].x + v[j].y * v[j].y) + (v[j].z * v[j].z + v[j].w * v[j].w); }
    const float rstd = 1.f / sqrtf(wave_sum(s) * (1.f / DM) + EPS);
#pragma unroll
    for (int j = 0; j < 4; ++j) { const f32x4 gg = gr[64 * j]; xr[64 * j] = v[j] * rstd * gg; }
}

struct Args { In in; float* out; unsigned char* ws; int ph_lo, ph_hi; int reps[4]; };
__global__ void __launch_bounds__(NWAVES * 64, 2) fwd_kernel(Args args) {
    extern __shared__ __attribute__((aligned(16))) unsigned char lds[];
    Frame F;
    F.lds = (LAS unsigned char*)lds;
    F.MISC = (volatile LAS unsigned*)(F.lds + MISC_OFF);
    F.tid = threadIdx.x; F.lane = F.tid & 63; F.wave = __builtin_amdgcn_readfirstlane(F.tid >> 6);
    F.G = gridDim.x; { const int bx = blockIdx.x; F.vcu = (F.G % 8 == 0) ? (bx % 8) * (F.G / 8) + bx / 8 : bx; }
    unsigned char* ws = args.ws;
    F.ctl = (gu32*)(ws + WS_CTL);
    for (int u = F.tid; u < (LDS_BYTES - LDSCTL_OFF) / 4; u += NWAVES * 64) ((LAS unsigned*)(F.lds + LDSCTL_OFF))[u] = 0u;
    __syncthreads();
    constexpr bool PER_PHASE = (MK_N_LAUNCHES != 1);
    XcdBarrier bar; bar.bar = (unsigned*)(F.ctl + CW_BAR); bar.x = 0; bar.st = nullptr;
    if (!PER_PHASE) bar = xcd_barrier_post((unsigned*)(F.ctl + CW_BAR), F.MISC + 8);
#define GRID_BAR() do { if (!PER_PHASE) xcd_barrier(bar); } while (0)
    const int lo = args.ph_lo, hi = args.ph_hi;
#define IN(k) (lo <= (k) && (k) < hi)
#define BOTH(k) (IN(k) && IN((k) + 1))
    const In& in = args.in;
    bf16* XN = (bf16*)(ws + WS_XN);

    if (IN(0)) { p0_prologue(F, in, ws); if (BOTH(0)) GRID_BAR(); }
    if (IN(1)) {
        pg8::Gemm g{XN, (const bf16*)(ws + WS_WIN), M, N1, DM}; pg8::StaticOrder S; S.init(M, N1, F.G, (int)blockIdx.x);
        EpiInProj E{(bf16*)(ws + WS_QN), (bf16*)(ws + WS_KV), (bf16*)(ws + WS_SB), (bf16*)(ws + WS_GM), (float*)(ws + WS_GN)};
        pg8::gemm_phase<EpiInProj, pg8::StaticOrder, true, true>(F.lds + RING_OFF, g, S, E);
        if (BOTH(1)) GRID_BAR();
    }
    if (IN(2)) {
        for (int rep = 0; rep < args.reps[0]; ++rep)
        for (int i = F.vcu; i < 256; i += F.G) { const int kv = i >> 7, b = (i >> 3) & 15, g = (i >> 2) & 1, cc = i & 3;
            att::cmp_unit(F, ws, kv ? in.p[10] : in.p[6], kv, b, g, cc); }
        if (BOTH(2)) GRID_BAR();
    }
    if (IN(3)) {
        for (int rep = 0; rep < args.reps[1]; ++rep)
        for (int i = F.vcu; i < 1024; i += F.G) { const int v = i & 255, k = i >> 8, bg = v >> 3, s = v & 7;
            const int j = (k == 0) ? s : (k == 1) ? 15 - s : (k == 2) ? 16 + s : 31 - s;
            att::nsa_unit(F, ws, in.p[3], bg >> 1, bg & 1, j); }
        for (int rep = 0; rep < args.reps[2]; ++rep)
        for (int i = F.vcu; i < 1024; i += F.G) { const int v = i & 255, k = i >> 8, bh = v >> 1, s = v & 1;
            const int qb = (k == 0) ? s : (k == 1) ? 3 - s : (k == 2) ? 4 + s : 7 - s;
            att::sb_unit(F, ws, bh >> 3, bh & 7, qb); }
        __syncthreads();
        if (BOTH(3)) GRID_BAR();
    }
    if (IN(4)) {
        { pg8::Gemm g{(const bf16*)(ws + WS_ONSA), (const bf16*)(ws + WS_WN), M, DM, 512}; pg8::StaticOrder S; S.init(M, DM, F.G, (int)blockIdx.x);
          EpiUp<false> E{(bf16*)(ws + WS_MIX), (const bf16*)(ws + WS_GM)};
          pg8::gemm_phase<EpiUp<false>, pg8::StaticOrder, true, true>(F.lds + RING_OFF, g, S, E); }
        asm volatile("s_waitcnt vmcnt(0)" ::: "memory"); __syncthreads();
        { pg8::Gemm g{(const bf16*)(ws + WS_OSB), (const bf16*)(ws + WS_WSB), M, DM, 512}; pg8::StaticOrder S; S.init(M, DM, F.G, (int)blockIdx.x);
          EpiUp<true> E{(bf16*)(ws + WS_MIX), (const bf16*)(ws + WS_GM) + 1024};
          pg8::gemm_phase<EpiUp<true>, pg8::StaticOrder, true, true>(F.lds + RING_OFF, g, S, E); }
        if (BOTH(4)) GRID_BAR();
    }
    if (IN(5)) {
        pg8::Gemm g{(const bf16*)(ws + WS_MIX), (const bf16*)(ws + WS_WO), M, DM, DM}; pg8::StaticOrder S; S.init(M, DM, F.G, (int)blockIdx.x);
        EpiOut E{in.p[0], args.out, (bf16*)(ws + WS_X1B), (float*)(ws + WS_ROWSS)};
        pg8::gemm_phase<EpiOut, pg8::StaticOrder, true, true>(F.lds + RING_OFF, g, S, E);
        if (BOTH(5)) GRID_BAR();
    }
    if (IN(6)) {
        pg8::Gemm g{(const bf16*)(ws + WS_X1B), (const bf16*)(ws + WS_W1), M, FF, DM}; pg8::StaticOrder S; S.init(M, FF, F.G, (int)blockIdx.x);
        EpiFF1 E{(bf16*)(ws + WS_F), (const float*)(ws + WS_ROWSS)};
        pg8::gemm_phase<EpiFF1, pg8::StaticOrder, true, true>(F.lds + RING_OFF, g, S, E);
        if (BOTH(6)) GRID_BAR();
    }
    if (IN(7)) {
        pg8::Gemm g{(const bf16*)(ws + WS_F), (const bf16*)(ws + WS_W2), M, DM, FF}; pg8::StaticOrder S; S.init(M, DM, F.G, (int)blockIdx.x);
        EpiFF2 E{args.out};
        pg8::gemm_phase<EpiFF2, pg8::StaticOrder, true, true>(F.lds + RING_OFF, g, S, E);
        if (BOTH(7)) GRID_BAR();
    }
    if (IN(8)) {
        const int gw = F.vcu * NWAVES + F.wave, NGW = F.G * NWAVES;
        const int lane8 = (int)__builtin_amdgcn_mbcnt_hi(~0u, __builtin_amdgcn_mbcnt_lo(~0u, 0u));
        for (int m = gw; m < M; m += NGW) final_norm_row(lane8, args.out + (size_t)m * DM, in.p[18]);
    }
#undef IN
#undef BOTH
}

extern "C" void kernel_launch(void* const* d_in, const int* in_sizes, int n_in, void* d_out, int out_size, void* d_ws, size_t ws_size, hipStream_t stream) {
    static int grid = 0;
    if (grid == 0) {
        if (n_in != 19 || in_sizes[0] != M * DM || out_size != M * DM || ws_size < WS_END) { fprintf(stderr, "kernel_launch: unexpected shapes (n_in %d, in0 %d, out %d, ws %zu); nothing launched\n", n_in, n_in > 0 ? in_sizes[0] : -1, out_size, ws_size); grid = -1; return; }
        int dev = 0, cus = 0, per_cu = 0;
        if (hipGetDevice(&dev) != hipSuccess || hipDeviceGetAttribute(&cus, hipDeviceAttributeMultiprocessorCount, dev) != hipSuccess) { grid = -1; return; }
        if (hipFuncSetAttribute((const void*)fwd_kernel, hipFuncAttributeMaxDynamicSharedMemorySize, LDS_BYTES) != hipSuccess) { fprintf(stderr, "kernel_launch: hipFuncSetAttribute failed\n"); grid = -1; return; }
        if (hipOccupancyMaxActiveBlocksPerMultiprocessor(&per_cu, (const void*)fwd_kernel, NWAVES * 64, LDS_BYTES) != hipSuccess || per_cu < 1) { fprintf(stderr, "kernel_launch: occupancy query reports %d blocks per CU\n", per_cu); per_cu = 1; }
        (void)hipGetLastError();
        grid = cus;
    }
    if (grid < 0) return;
    (void)hipMemsetAsync((char*)d_ws + WS_CTL, 0, CTL_ZERO_BYTES, stream);
    Args a{};
    for (int i = 0; i < 19; ++i) a.in.p[i] = (const float*)d_in[i];
    a.out = (float*)d_out; a.ws = (unsigned char*)d_ws;
    a.reps[0] = REP_CMP; a.reps[1] = REP_NSA; a.reps[2] = REP_SB; a.reps[3] = 1;
    if (MK_N_LAUNCHES == 1) {
        a.ph_lo = 0; a.ph_hi = N_PHASES;
        hipLaunchKernelGGL(fwd_kernel, dim3(grid), dim3(NWAVES * 64), LDS_BYTES, stream, a);
    } else {
        for (int li = 0; li < 9; ++li) { a.ph_lo = li; a.ph_hi = li + 1;
            hipLaunchKernelGGL(fwd_kernel, dim3(grid), dim3(NWAVES * 64), LDS_BYTES, stream, a); }
    }
}
```

```cpp
#include <hip/hip_runtime.h>
#include <cstdio>
#include <cstdint>
namespace pg8 {
#define PG8_LAS __attribute__((address_space(3)))
typedef unsigned short bf16_t;
typedef short bf16x8 __attribute__((ext_vector_type(8)));
typedef float f32x4 __attribute__((ext_vector_type(4)));
typedef unsigned u32x4 __attribute__((ext_vector_type(4)));
constexpr int BM = 256, BK = 64, HALF = 128, HTB = HALF * BK * 2  , STAGE_BYTES = 8 * HTB, NXCD = 8, WGM = 8;

__host__ __device__ __forceinline__ int lds_byte(int r, int c) { const int st = (r >> 4) * 2 + (c >> 5), rr = r & 15, cc = c & 31, ob = rr * 64 + cc * 2; return st * 1024 + (ob ^ (((ob >> 9) & 1) << 5)); }
__host__ __device__ __forceinline__ void stage_rc(int b, int& R, int& C) { const int st = b / 1024, sb = b % 1024, swz = sb ^ (((sb >> 9) & 1) << 5); R = (st >> 1) * 16 + swz / 64; C = (st & 1) * 32 + (swz % 64) / 2; }
__host__ __device__ __forceinline__ int perm32(int rho) { const int n = rho >> 4, i = rho & 15; return 8 * (i >> 2) + 4 * n + (i & 3); }

struct Unit { int pm, pn; };
struct Gemm { const bf16_t* A; const bf16_t* Bt; int M, N, K; };

struct StaticOrder {
    int nM, nN, nwg, G, c;
    __host__ __device__ void init(int M, int N, int G_, int c_) { nM = M / BM; nN = N / BM; nwg = nM * nN; G = G_; c = c_; }
    __host__ __device__ bool next(int i, Unit& u) const {
        const long L = (long)i * G + c; if (L >= nwg) return false;
        int wgid = (int)L; { const int q = nwg / NXCD, r = nwg % NXCD, xcd = wgid % NXCD, off = wgid / NXCD; wgid = (xcd < r ? xcd * (q + 1) : r * (q + 1) + (xcd - r) * q) + off; }
        const int nig = WGM * nN, gid = wgid / nig, fm = gid * WGM, gsz = (nM - fm) < WGM ? (nM - fm) : WGM;
        u.pm = fm + ((wgid % nig) % gsz); u.pn = (wgid % nig) / gsz; return true;
    }
    __device__ __forceinline__ void a_ready(const Unit&) const {}
    __device__ __forceinline__ void done(const Unit&) const {}
};

__device__ __forceinline__ unsigned cvt_pk_bf16(float lo, float hi) { unsigned r; asm volatile("v_cvt_pk_bf16_f32 %0, %1, %2" : "=v"(r) : "v"(lo), "v"(hi)); return r; }
typedef float f32x2 __attribute__((ext_vector_type(2)));
template <class Epi, class Sched, bool ALIGN_EPI = false, bool SP2 = false>
__device__ __forceinline__ void gemm_phase(PG8_LAS unsigned char* lds, const Gemm g, const Sched& S, const Epi& E) {
    const int tid = threadIdx.x, wid = __builtin_amdgcn_readfirstlane(tid >> 6), lane = tid & 63, wr = wid >> 2, wc = wid & 3, fr = lane & 15, fq = lane >> 4;
    const int K = g.K, nt = K / BK;
    unsigned voffA[2], voffB[2];
#pragma unroll
    for (int i = 0; i < 2; ++i) { int R, C; stage_rc(tid * 16 + i * 8192, R, C); const int Rb = Epi::PERM ? ((R & ~31) + perm32(R & 31)) : R;
        voffA[i] = (unsigned)(R * K + C) * 2u; voffB[i] = (unsigned)(Rb * K + C) * 2u; }
    const size_t kstep = (size_t)(BK * 2);
    const size_t hstep = (size_t)HALF * K * 2;
    const size_t tstep = 2 * hstep;
    const unsigned ldsw = (unsigned)wid * 1024u;
    const int aoff = lds_byte(wr * 64 + fr, fq * 8), boff = lds_byte(wc * 32 + fr, fq * 8);
#define PG8_SA(b, h) (((b) * 2 + (h)) * HTB)
#define PG8_SB(b, h) ((4 + (b) * 2 + (h)) * HTB)
#define PG8_STAGE(bufoff, gbase, voff) do { _Pragma("unroll") for (int _i = 0; _i < 2; ++_i) \
        __builtin_amdgcn_global_load_lds((const unsigned*)((const char*)(gbase) + (voff)[_i]), (PG8_LAS unsigned*)(lds + (bufoff) + ldsw + _i * 8192), 16, 0, 0); } while (0)
#define PG8_LDA(dst, b, h) do { _Pragma("unroll") for (int m = 0; m < 4; ++m) _Pragma("unroll") for (int k = 0; k < 2; ++k) dst[m][k] = *(const PG8_LAS bf16x8*)(lds + PG8_SA(b, h) + aoff + m * 2048 + k * 1024); } while (0)
#define PG8_LDB(dst, b, h) do { _Pragma("unroll") for (int n = 0; n < 2; ++n) _Pragma("unroll") for (int k = 0; k < 2; ++k) dst[n][k] = *(const PG8_LAS bf16x8*)(lds + PG8_SB(b, h) + boff + n * 2048 + k * 1024); } while (0)
#define PG8_MMA(ai, bj, At, Bt) do { __builtin_amdgcn_s_setprio(1); _Pragma("unroll") for (int m = 0; m < 4; ++m) _Pragma("unroll") for (int n = 0; n < 2; ++n) _Pragma("unroll") for (int k = 0; k < 2; ++k) \
        acc[ai][bj][m][n] = __builtin_amdgcn_mfma_f32_16x16x32_bf16(Bt[n][k], At[m][k], acc[ai][bj][m][n], 0, 0, 0); __builtin_amdgcn_s_setprio(0); } while (0)
#define PG8_WAIT_V(n) asm volatile("s_waitcnt vmcnt(" #n ")" ::: "memory")
#define PG8_WAIT_L(n) asm volatile("s_waitcnt lgkmcnt(" #n ")" ::: "memory")
#define PG8_BAR __builtin_amdgcn_s_barrier()
#define PG8_SCHED __builtin_amdgcn_sched_barrier(0)
    Unit cur, nxt; int ui = 0;
    if (!S.next(0, cur)) return;
    f32x4 acc[2][2][4][2];
#pragma unroll
    for (int a = 0; a < 2; ++a)
#pragma unroll
        for (int b = 0; b < 2; ++b)
#pragma unroll
            for (int m = 0; m < 4; ++m)
#pragma unroll
                for (int n = 0; n < 2; ++n) acc[a][b][m][n] = (f32x4){0.f, 0.f, 0.f, 0.f};
    bf16x8 At[4][2], B0[2][2], B1[2][2];
    const char* cA = (const char*)g.A + (size_t)cur.pm * tstep; const char* cB = (const char*)g.Bt + (size_t)cur.pn * tstep;
    S.a_ready(cur);
    if constexpr (SP2) {
        PG8_STAGE(PG8_SB(0, 0), cB, voffB); PG8_STAGE(PG8_SB(0, 1), cB + hstep, voffB); PG8_STAGE(PG8_SA(0, 0), cA, voffA); PG8_STAGE(PG8_SA(0, 1), cA + hstep, voffA);
        if (wr == 1) PG8_BAR;
        PG8_WAIT_V(2); PG8_BAR;
        PG8_STAGE(PG8_SB(1, 0), cB + kstep, voffB); PG8_STAGE(PG8_SA(1, 0), cA + kstep, voffA); PG8_STAGE(PG8_SB(1, 1), cB + hstep + kstep, voffB);
        PG8_WAIT_V(6); PG8_BAR;
    } else {
        PG8_STAGE(PG8_SB(0, 0), cB, voffB); PG8_STAGE(PG8_SA(0, 0), cA, voffA); PG8_STAGE(PG8_SB(0, 1), cB + hstep, voffB); PG8_STAGE(PG8_SA(0, 1), cA + hstep, voffA);
        if (wr == 1) PG8_BAR;
        PG8_WAIT_V(4); PG8_BAR;
        PG8_STAGE(PG8_SB(1, 0), cB + kstep, voffB); PG8_STAGE(PG8_SA(1, 0), cA + kstep, voffA); PG8_STAGE(PG8_SB(1, 1), cB + hstep + kstep, voffB);
        PG8_WAIT_V(6); PG8_BAR;
    }
    for (;;) {
        const bool has_next = S.next(ui + 1, nxt);
        const char* nA = has_next ? (const char*)g.A + (size_t)nxt.pm * tstep : cA; const char* nB = has_next ? (const char*)g.Bt + (size_t)nxt.pn * tstep : cB;
        for (int t = 0; t < nt; t += 2) {
            const bool last = (t == nt - 2);
            const char* a1 = cA + (size_t)(t + 1) * kstep;
            const char* a2 = last ? nA : cA + (size_t)(t + 2) * kstep; const char* b2 = last ? nB : cB + (size_t)(t + 2) * kstep;
            const char* a3 = a2 + kstep; const char* b3 = b2 + kstep;
            if (last && has_next) S.a_ready(nxt);
            if constexpr (SP2) {
            PG8_LDB(B0, 0, 0); PG8_LDB(B1, 0, 1); PG8_SCHED; PG8_LDA(At, 0, 0); PG8_STAGE(PG8_SA(1, 1), a1 + hstep, voffA);
            PG8_WAIT_V(8); PG8_WAIT_L(0); PG8_BAR; PG8_MMA(0, 0, At, B0); PG8_MMA(0, 1, At, B1); PG8_BAR; PG8_SCHED;
            PG8_LDA(At, 0, 1); PG8_STAGE(PG8_SB(0, 0), b2, voffB); PG8_STAGE(PG8_SB(0, 1), b2 + hstep, voffB); PG8_STAGE(PG8_SA(0, 0), a2, voffA);
            PG8_WAIT_V(8); PG8_WAIT_L(0); PG8_BAR; PG8_MMA(1, 0, At, B0); PG8_MMA(1, 1, At, B1); PG8_BAR; PG8_SCHED;
            PG8_LDB(B0, 1, 0); PG8_LDB(B1, 1, 1); PG8_SCHED; PG8_LDA(At, 1, 0); PG8_STAGE(PG8_SA(0, 1), a2 + hstep, voffA);
            PG8_WAIT_V(8); PG8_WAIT_L(0); PG8_BAR; PG8_MMA(0, 0, At, B0); PG8_MMA(0, 1, At, B1); PG8_BAR; PG8_SCHED;
            PG8_LDA(At, 1, 1); PG8_STAGE(PG8_SB(1, 0), b3, voffB); PG8_STAGE(PG8_SB(1, 1), b3 + hstep, voffB); PG8_STAGE(PG8_SA(1, 0), a3, voffA);
            PG8_WAIT_V(8); PG8_WAIT_L(0); PG8_BAR; PG8_MMA(1, 0, At, B0); PG8_MMA(1, 1, At, B1); PG8_BAR; PG8_SCHED;
            } else {
            PG8_LDB(B0, 0, 0); PG8_SCHED; PG8_LDA(At, 0, 0); PG8_STAGE(PG8_SA(1, 1), a1 + hstep, voffA);
            PG8_WAIT_L(8); PG8_BAR; PG8_WAIT_L(0); PG8_MMA(0, 0, At, B0); PG8_BAR; PG8_SCHED;
            PG8_LDB(B1, 0, 1); PG8_STAGE(PG8_SB(0, 0), b2, voffB);
            PG8_BAR; PG8_WAIT_L(0); PG8_MMA(0, 1, At, B1); PG8_BAR;
            PG8_LDA(At, 0, 1); PG8_STAGE(PG8_SA(0, 0), a2, voffA);
            PG8_BAR; PG8_WAIT_L(0); PG8_MMA(1, 0, At, B0); PG8_BAR; PG8_SCHED;
            PG8_STAGE(PG8_SB(0, 1), b2 + hstep, voffB);
            PG8_WAIT_V(6); PG8_BAR; PG8_MMA(1, 1, At, B1); PG8_BAR;
            PG8_LDB(B0, 1, 0); PG8_SCHED; PG8_LDA(At, 1, 0); PG8_STAGE(PG8_SA(0, 1), a2 + hstep, voffA);
            PG8_WAIT_L(8); PG8_BAR; PG8_WAIT_L(0); PG8_MMA(0, 0, At, B0); PG8_BAR; PG8_SCHED;
            PG8_LDB(B1, 1, 1); PG8_STAGE(PG8_SB(1, 0), b3, voffB);
            PG8_BAR; PG8_WAIT_L(0); PG8_MMA(0, 1, At, B1); PG8_BAR;
            PG8_LDA(At, 1, 1); PG8_STAGE(PG8_SA(1, 0), a3, voffA);
            PG8_BAR; PG8_WAIT_L(0); PG8_MMA(1, 0, At, B0); PG8_BAR; PG8_SCHED;
            PG8_STAGE(PG8_SB(1, 1), b3 + hstep, voffB);
            PG8_WAIT_V(6); PG8_BAR; PG8_MMA(1, 1, At, B1); PG8_BAR;
            }
        }
        if constexpr (ALIGN_EPI) { if (wr == 0) PG8_BAR; }
        if constexpr (!Epi::AFTER_DRAIN) { E(acc, cur, wr, wc, fr, fq); S.done(cur); }
        if (!has_next) break;
#pragma unroll
        for (int a = 0; a < 2; ++a)
#pragma unroll
            for (int b = 0; b < 2; ++b)
#pragma unroll
                for (int m = 0; m < 4; ++m)
#pragma unroll
                    for (int n = 0; n < 2; ++n) acc[a][b][m][n] = (f32x4){0.f, 0.f, 0.f, 0.f};
        cur = nxt; cA = nA; cB = nB; ++ui;
        if constexpr (ALIGN_EPI) { if (wr == 1) PG8_BAR; }
    }
    PG8_WAIT_V(0);
    if constexpr (!ALIGN_EPI) { if (wr == 0) PG8_BAR; }
    PG8_BAR;
    if constexpr (Epi::AFTER_DRAIN) { E.fused(acc, cur, wr, wc, fr, fq, lds, wid, lane); S.done(cur); }
#undef PG8_SA
#undef PG8_SB
#undef PG8_STAGE
#undef PG8_LDA
#undef PG8_LDB
#undef PG8_MMA
#undef PG8_WAIT_V
#undef PG8_WAIT_L
#undef PG8_BAR
#undef PG8_SCHED
}
}
#define GAS __attribute__((address_space(1)))
#define LAS __attribute__((address_space(3)))
typedef unsigned short bf16;
typedef unsigned v4u __attribute__((ext_vector_type(4)));
typedef float f32x4 __attribute__((ext_vector_type(4)));
typedef short bf16x8 __attribute__((ext_vector_type(8)));
typedef GAS unsigned gu32;
typedef GAS unsigned long long gu64;
#define RLX_AGENT __ATOMIC_RELAXED, __HIP_MEMORY_SCOPE_AGENT
#define LDS_WAIT() asm volatile("s_waitcnt lgkmcnt(0)" ::: "memory")
#define VM_WAIT() asm volatile("s_waitcnt vmcnt(0)" ::: "memory")
__device__ __forceinline__ unsigned long long rt() { return __builtin_amdgcn_s_memrealtime(); }
__device__ __forceinline__ unsigned f2bf(float f) { unsigned u = __builtin_bit_cast(unsigned, f); return (u + 0x7fffu + ((u >> 16) & 1u)) >> 16; }
__device__ __forceinline__ unsigned pk2(float lo, float hi) { return f2bf(lo) | (f2bf(hi) << 16); }

#define XB_TMO      128
#define XB_XCNT(j)  (256  + 64 * (j))
#define XB_XSUB(j)  (1280 + 64 * (j))
#define XB_XGEN(j)  (2304 + 64 * (j))
#define XB_TOP      3328
#define XB_TOPGEN   3392
#define XCD_BAR_WORDS 3456
#define XB_SPIN_CAP (1u << 18)

__device__ __forceinline__ unsigned xb_ld(unsigned* p)              { return __hip_atomic_load(p, __ATOMIC_RELAXED, __HIP_MEMORY_SCOPE_AGENT); }
__device__ __forceinline__ unsigned xb_add(unsigned* p, unsigned v) { return __hip_atomic_fetch_add(p, v, __ATOMIC_RELAXED, __HIP_MEMORY_SCOPE_AGENT); }
__device__ __forceinline__ unsigned xb_xcc_id() { return (unsigned)__builtin_amdgcn_s_getreg((3 << 11) | 20) & 0xFu; }
#define XB_SPIN(cond, bar) do { unsigned _sp = 0; while (cond) { __builtin_amdgcn_s_sleep(1); \
    if ((++_sp & 255u) == 0u) { if (xb_ld(&(bar)[XB_TMO])) break; if (_sp > XB_SPIN_CAP) { atomicAdd(&(bar)[XB_TMO], 1u); break; } } } } while (0)

struct XcdBarrier {
    unsigned* bar; unsigned x;
    volatile LAS unsigned* st;
};

__device__ __forceinline__ XcdBarrier xcd_barrier_post(unsigned* bar, volatile LAS unsigned* st) {
    XcdBarrier b; b.bar = bar; b.x = xb_xcc_id(); b.st = st;
    if (threadIdx.x == 0) (void)xb_add(&bar[XB_XCNT(b.x)], 1u);
    return b;
}
__device__ __forceinline__ void xcd_barrier_complete(unsigned* bar, unsigned x, unsigned& nloc, unsigned& nx) {
    const unsigned G = gridDim.x * gridDim.y * gridDim.z;
    unsigned sum, cnt, mine, sp = 0u;
    for (;;) {
        sum = 0u; cnt = 0u; mine = 0u;
#pragma unroll
        for (unsigned j = 0; j < 16; ++j) { const unsigned c = xb_ld(&bar[XB_XCNT(j)]); sum += c; cnt += (c > 0u) ? 1u : 0u; mine = (j == x) ? c : mine; }
        if (sum == G) break;
        __builtin_amdgcn_s_sleep(1);
        if ((++sp & 255u) == 0u) { if (xb_ld(&bar[XB_TMO])) break; if (sp > XB_SPIN_CAP) { atomicAdd(&bar[XB_TMO], 1u); break; } }
    }
    nloc = mine > 0u ? mine : 1u; nx = cnt > 0u ? cnt : 1u;
}

__device__ __forceinline__ void xcd_barrier(const XcdBarrier& b) {
    asm volatile("s_waitcnt vmcnt(0)" ::: "memory");
    __syncthreads();
    if (threadIdx.x == 0) {
        unsigned* bar = b.bar;
        __builtin_amdgcn_s_waitcnt(0);
        unsigned nloc = b.st[0], nx = b.st[1];
        if (nloc == 0u) { xcd_barrier_complete(bar, b.x, nloc, nx); b.st[0] = nloc; b.st[1] = nx; }
        const unsigned old = xb_add(&bar[XB_XSUB(b.x)], 1u);
        const unsigned gen = old / nloc;
        if (old + 1u == (gen + 1u) * nloc) {
            __builtin_amdgcn_fence(__ATOMIC_RELEASE, "agent");
            asm volatile("s_waitcnt vmcnt(0)" ::: "memory");
            const unsigned og = xb_add(&bar[XB_TOP], 1u);
            const unsigned tg = og / nx;
            if (og + 1u == (tg + 1u) * nx) xb_add(&bar[XB_TOPGEN], 1u);
            else XB_SPIN(xb_ld(&bar[XB_TOPGEN]) == tg, bar);
            __builtin_amdgcn_fence(__ATOMIC_ACQUIRE, "agent");
            xb_add(&bar[XB_XGEN(b.x)], 1u);
            asm volatile("s_waitcnt vmcnt(0)" ::: "memory");
        } else {
            XB_SPIN(xb_ld(&bar[XB_XGEN(b.x)]) == gen, bar);
            __builtin_amdgcn_fence(__ATOMIC_ACQUIRE, "agent");
            asm volatile("s_waitcnt vmcnt(0)" ::: "memory");
        }
    }
    __syncthreads();
}

typedef float f32x16 __attribute__((ext_vector_type(16)));
typedef short s16x4 __attribute__((ext_vector_type(4)));
typedef unsigned v2u __attribute__((ext_vector_type(2)));

constexpr int NWAVES = 8;
constexpr int BATCH = 16, SEQ = 2048, DM = 1024, M = BATCH * SEQ;
constexpr int FF = 4096;
constexpr int IN_COLS = 4888, N1 = 5120;
constexpr float EPS = 1e-6f;
constexpr float LOG2E = 1.4426950408889634f;
constexpr float QSCALE = 0.125f * LOG2E;
constexpr float NEGBIG = -1e30f;

__constant__ unsigned char T5B[129] = {0,1,2,3,4,5,6,7,8,9,10,11,12,13,14,15,16,16,16,17,17,18,18,18,19,19,19,20,20,20,20,21,21,21,21,22,22,22,22,22,23,23,23,23,23,23,24,24,24,24,24,24,25,25,25,25,25,25,25,26,26,26,26,26,26,26,26,27,27,27,27,27,27,27,27,27,27,28,28,28,28,28,28,28,28,28,28,29,29,29,29,29,29,29,29,29,29,29,29,30,30,30,30,30,30,30,30,30,30,30,30,30,30,31,31,31,31,31,31,31,31,31,31,31,31,31,31,31,31};

constexpr size_t MiB = 1u << 20;
constexpr size_t WS_CTL = 0, CTL_ZERO_BYTES = 1 * MiB;
constexpr size_t WS_ROWSS = 512 * 1024;
constexpr size_t WS_B1P = 768 * 1024;
constexpr size_t WS_WIN = 2 * MiB, WS_WN = 12 * MiB, WS_WSB = 13 * MiB, WS_WO = 14 * MiB, WS_W1 = 16 * MiB, WS_W2 = 24 * MiB;
constexpr size_t WS_CW1K = 32 * MiB, WS_CW1V = 33 * MiB, WS_CW2K = 34 * MiB, WS_CW2V = 34 * MiB + 65536;
constexpr size_t WS_KC = 35 * MiB, WS_VC = 36 * MiB;
constexpr size_t WS_XN = 40 * MiB;
constexpr size_t WS_QN = 104 * MiB;
constexpr size_t WS_KV = 136 * MiB;
constexpr size_t WS_SB = 184 * MiB;
constexpr size_t WS_GN = 280 * MiB;
constexpr size_t WS_GM = 284 * MiB;
constexpr size_t WS_END = 412 * MiB;
constexpr size_t WS_ONSA = 40 * MiB, WS_OSB = 72 * MiB;
constexpr size_t WS_MIX = 184 * MiB;
constexpr size_t WS_F = 40 * MiB;
constexpr size_t WS_X1B = 348 * MiB;
constexpr size_t KVARR = (size_t)BATCH * 2 * SEQ * 64;
constexpr size_t SBARR = (size_t)BATCH * 8 * SEQ * 64;
constexpr int CW_BAR = 4096;

constexpr int RING_OFF = 0, RING_BYTES = 131072;
constexpr int LDSCTL_OFF = RING_BYTES, MISC_OFF = LDSCTL_OFF + 320;
constexpr int LDS_BYTES = 147456;

#ifndef MK_N_LAUNCHES
#define MK_N_LAUNCHES 1
#endif
constexpr int N_PHASES = 10;
#ifndef REP_CMP
#define REP_CMP 1
#endif
#ifndef REP_NSA
#define REP_NSA 1
#endif
#ifndef REP_SB
#define REP_SB 1
#endif

struct Frame {
    LAS unsigned char* lds;
    volatile LAS unsigned* MISC;
    gu32* ctl;
    int tid, lane, wave;
    int vcu, G;
};

__device__ __forceinline__ float wave_sum(float v) {
#pragma unroll
    for (int o = 1; o < 64; o <<= 1) v += __shfl_xor(v, o);
    return v;
}
__device__ __forceinline__ float bf2f(unsigned short b) { return __builtin_bit_cast(float, (unsigned)b << 16); }
__device__ __forceinline__ float fast_exp2(float x) { return __builtin_amdgcn_exp2f(x); }
__device__ __forceinline__ float fast_sigmoid(float x) { return __builtin_amdgcn_rcpf(1.0f + fast_exp2(-x * LOG2E)); }
typedef float f32x2_t __attribute__((ext_vector_type(2))); typedef __bf16 bf16x2_t __attribute__((ext_vector_type(2)));
__device__ __forceinline__ unsigned cvtpk(float lo, float hi) { f32x2_t v = {lo, hi}; bf16x2_t b = __builtin_convertvector(v, bf16x2_t); return __builtin_bit_cast(unsigned, b); }

__device__ __forceinline__ void transpose_item(const float* W, int K, int ldn, int n0, const float* kscale, bf16* WT, int drow0, LAS float* scr, int kb, int lane) {
    const int k0 = 64 * kb;
    const int c = lane & 7;
    if (n0 < 0) {
#pragma unroll
        for (int j = 0; j < 4; ++j) { const int n = (lane >> 3) + 8 * j; *(GAS v4u*)(WT + (size_t)(drow0 + n) * K + k0 + 8 * c) = (v4u){0u, 0u, 0u, 0u}; }
        return;
    }
#pragma unroll 8
    for (int i = 0; i < 32; ++i) { const int kk = 2 * i + (lane >> 5); float v = W[(size_t)(k0 + kk) * ldn + n0 + (lane & 31)]; if (kscale) v *= kscale[k0 + kk]; scr[kk * 33 + (lane & 31)] = v; }
    LDS_WAIT(); asm volatile("" ::: "memory");
#pragma unroll
    for (int j = 0; j < 4; ++j) { const int n = (lane >> 3) + 8 * j; const LAS float* s = scr + (8 * c) * 33 + n;
        v4u o; o.x = pk2(s[0 * 33], s[1 * 33]); o.y = pk2(s[2 * 33], s[3 * 33]); o.z = pk2(s[4 * 33], s[5 * 33]); o.w = pk2(s[6 * 33], s[7 * 33]);
        *(GAS v4u*)(WT + (size_t)(drow0 + n) * K + k0 + 8 * c) = o; }
    LDS_WAIT(); asm volatile("" ::: "memory");
}
__device__ __forceinline__ void rms_row_to_bf16(int lane, const float* xrow, const float* g, bf16* orow) {
    const GAS f32x4* xr = (const GAS f32x4*)xrow + lane; const GAS f32x4* gr = (const GAS f32x4*)g + lane;
    f32x4 v[4]; float s = 0.f;
#pragma unroll
    for (int j = 0; j < 4; ++j) { v[j] = xr[64 * j]; s += (v[j].x * v[j].x + v[j].y * v[j].y) + (v[j].z * v[j].z + v[j].w * v[j].w); }
    const float rstd = 1.f / sqrtf(wave_sum(s) * (1.f / DM) + EPS);
    GAS unsigned long long* o8 = (GAS unsigned long long*)orow + lane;
#pragma unroll
    for (int j = 0; j < 4; ++j) { const f32x4 gg = gr[64 * j];
        o8[64 * j] = (unsigned long long)pk2(v[j].x * rstd * gg.x, v[j].y * rstd * gg.y) | ((unsigned long long)pk2(v[j].z * rstd * gg.z, v[j].w * rstd * gg.w) << 32); }
}
struct In { const float* p[19]; };
__device__ __forceinline__ void p0_prologue(Frame& F, const In& in, unsigned char* ws) {
    LAS float* scr = (LAS float*)(F.lds + RING_OFF + F.wave * 16384);
    const int gw = F.vcu * NWAVES + F.wave, NGW = F.G * NWAVES;
    constexpr int I_IN = 16 * 160, I_UP = 8 * 32, I_O = 16 * 32, I_1 = 16 * 128, I_2 = 64 * 32, I_C1 = 32 * 8, I_C2 = 4 * 2;
    constexpr int NITEMS = I_IN + 2 * I_UP + I_O + I_1 + I_2 + 2 * I_C1 + 2 * I_C2;
    for (int it = gw; it < NITEMS; it += NGW) {
        int r = it;
        if (r < I_IN) { const int kb = r / 160, nb = r % 160; const int d0 = nb * 32;
            const int n0 = d0 < 1280 ? d0 : (d0 < 4864 ? d0 + 24 : (d0 == 4864 ? 1280 : -1));
            transpose_item(in.p[2], 1024, IN_COLS, n0, nullptr, (bf16*)(ws + WS_WIN), d0, scr, kb, F.lane); continue; } r -= I_IN;
        if (r < I_UP) { transpose_item(in.p[12], 512, 1024, (r % 32) * 32, nullptr, (bf16*)(ws + WS_WN), (r % 32) * 32, scr, r / 32, F.lane); continue; } r -= I_UP;
        if (r < I_UP) { transpose_item(in.p[13], 512, 1024, (r % 32) * 32, nullptr, (bf16*)(ws + WS_WSB), (r % 32) * 32, scr, r / 32, F.lane); continue; } r -= I_UP;
        if (r < I_O) { transpose_item(in.p[14], 1024, 1024, (r % 32) * 32, nullptr, (bf16*)(ws + WS_WO), (r % 32) * 32, scr, r / 32, F.lane); continue; } r -= I_O;
        if (r < I_1) { transpose_item(in.p[16], 1024, 4096, (r % 128) * 32, in.p[15], (bf16*)(ws + WS_W1), (r % 128) * 32, scr, r / 128, F.lane); continue; } r -= I_1;
        if (r < I_2) { transpose_item(in.p[17], 4096, 1024, (r % 32) * 32, nullptr, (bf16*)(ws + WS_W2), (r % 32) * 32, scr, r / 32, F.lane); continue; } r -= I_2;
        if (r < I_C1) { transpose_item(in.p[5], 2048, 256, (r % 8) * 32, nullptr, (bf16*)(ws + WS_CW1K), (r % 8) * 32, scr, r / 8, F.lane); continue; } r -= I_C1;
        if (r < I_C1) { transpose_item(in.p[9], 2048, 256, (r % 8) * 32, nullptr, (bf16*)(ws + WS_CW1V), (r % 8) * 32, scr, r / 8, F.lane); continue; } r -= I_C1;
        if (r < I_C2) { transpose_item(in.p[7], 256, 64, (r % 2) * 32, nullptr, (bf16*)(ws + WS_CW2K), (r % 2) * 32, scr, r / 2, F.lane); continue; } r -= I_C2;
        transpose_item(in.p[11], 256, 64, (r % 2) * 32, nullptr, (bf16*)(ws + WS_CW2V), (r % 2) * 32, scr, r / 2, F.lane);
    }
    if (gw < 256) {
        const int kvm = gw >> 7, chunk = (gw >> 2) & 31, nq = gw & 3, n = 64 * nq + F.lane;
        const float* pe = in.p[kvm ? 8 : 4]; const float* w1 = in.p[kvm ? 9 : 5];
        float sum = 0.f;
#pragma unroll 16
        for (int kk = 0; kk < 64; ++kk) sum += pe[64 * chunk + kk] * w1[(size_t)(64 * chunk + kk) * 256 + n];
        atomicAdd((float*)(ws + WS_B1P) + kvm * 256 + n, sum);
    }
    bf16* XN = (bf16*)(ws + WS_XN);
    for (int m = gw; m < M; m += NGW) rms_row_to_bf16(F.lane, in.p[0] + (size_t)m * DM, in.p[1], XN + (size_t)m * DM);
}

__device__ __forceinline__ v4u pack8(const f32x4 a, const f32x4 b) { v4u w; w.x = cvtpk(a[0], a[1]); w.y = cvtpk(a[2], a[3]); w.z = cvtpk(b[0], b[1]); w.w = cvtpk(b[2], b[3]); return w; }
__device__ __forceinline__ f32x4 sig4(const f32x4 a) { f32x4 r; r[0] = fast_sigmoid(a[0]); r[1] = fast_sigmoid(a[1]); r[2] = fast_sigmoid(a[2]); r[3] = fast_sigmoid(a[3]); return r; }

struct EpiInProj {
    static constexpr bool PERM = true, AFTER_DRAIN = false;
    bf16 *QN, *KV, *SB, *GM; float* GN;
    __device__ __forceinline__ void operator()(const f32x4 (&acc)[2][2][4][2], const pg8::Unit& u, int wr, int wc, int fr, int fq) const {
        const int row0 = u.pm * 256 + wr * 64 + fr;
#pragma unroll
        for (int bj = 0; bj < 2; ++bj) {
            const int cb = u.pn * 256 + bj * 128;
            const int c = cb + wc * 32 + 8 * fq;
#pragma unroll
            for (int ai = 0; ai < 2; ++ai)
#pragma unroll
                for (int m = 0; m < 4; ++m) {
                    const int row = row0 + ai * 128 + m * 16; const int b = row >> 11, t = row & 2047;
                    f32x4 v0 = acc[ai][bj][m][0], v1 = acc[ai][bj][m][1];
                    if (cb < 512) { v0 = v0 * QSCALE; v1 = v1 * QSCALE; *(GAS v4u*)(QN + (size_t)row * 512 + c) = pack8(v0, v1); }
                    else if (cb < 1280) { const int cc = c - 512, a = cc >> 7, g = (cc >> 6) & 1, d = cc & 63;
                        *(GAS v4u*)(KV + ((((size_t)a * BATCH + b) * 2 + g) * SEQ + t) * 64 + d) = pack8(v0, v1); }
                    else if (cb < 2816) { const int cc = c - 1280, wh = cc >> 9, h = (cc >> 6) & 7, d = cc & 63;
                        if (wh == 0) { v0 = v0 * QSCALE; v1 = v1 * QSCALE; }
                        *(GAS v4u*)(SB + ((((size_t)wh * BATCH + b) * 8 + h) * SEQ + t) * 64 + d) = pack8(v0, v1); }
                    else if (cb < 4864) { *(GAS v4u*)(GM + (size_t)row * 2048 + (c - 2816)) = pack8(sig4(v0), sig4(v1)); }
                    else { const int cc = c - 4864; if (cc < 24) { GAS f32x4* o = (GAS f32x4*)(GN + (size_t)row * 24 + cc); o[0] = sig4(v0); o[1] = sig4(v1); } }
                }
        }
    }
};
template <bool SECOND> struct EpiUp {
    static constexpr bool PERM = true, AFTER_DRAIN = false;
    bf16* MIX; const bf16* GMg;
    __device__ __forceinline__ void operator()(const f32x4 (&acc)[2][2][4][2], const pg8::Unit& u, int wr, int wc, int fr, int fq) const {
        const int row0 = u.pm * 256 + wr * 64 + fr;
#pragma unroll
        for (int ai = 0; ai < 2; ++ai)
#pragma unroll
            for (int m = 0; m < 4; ++m) { const int row = row0 + ai * 128 + m * 16;
#pragma unroll
                for (int bj = 0; bj < 2; ++bj) { const int c = u.pn * 256 + bj * 128 + wc * 32 + 8 * fq;
                    const v4u gw = *(const GAS v4u*)(GMg + (size_t)row * 2048 + c);
                    float r[8];
#pragma unroll
                    for (int q = 0; q < 4; ++q) { r[2 * q] = __builtin_bit_cast(float, gw[q] << 16); r[2 * q + 1] = __builtin_bit_cast(float, gw[q] & 0xffff0000u); }
                    f32x4 v0 = acc[ai][bj][m][0], v1 = acc[ai][bj][m][1];
#pragma unroll
                    for (int q = 0; q < 4; ++q) { v0[q] *= r[q]; v1[q] *= r[4 + q]; }
                    GAS v4u* dst = (GAS v4u*)(MIX + (size_t)row * 1024 + c);
                    if (SECOND) { const v4u pw = *dst;
#pragma unroll
                        for (int q = 0; q < 2; ++q) { v0[2 * q] += __builtin_bit_cast(float, pw[q] << 16); v0[2 * q + 1] += __builtin_bit_cast(float, pw[q] & 0xffff0000u);
                                                      v1[2 * q] += __builtin_bit_cast(float, pw[2 + q] << 16); v1[2 * q + 1] += __builtin_bit_cast(float, pw[2 + q] & 0xffff0000u); } }
                    *dst = pack8(v0, v1); } }
    }
};
struct EpiOut {
    static constexpr bool PERM = true, AFTER_DRAIN = false;
    const float* X; float* X1; bf16* X1B; float* rowss;
    __device__ __forceinline__ void operator()(const f32x4 (&acc)[2][2][4][2], const pg8::Unit& u, int wr, int wc, int fr, int fq) const {
        const int row0 = u.pm * 256 + wr * 64 + fr;
#pragma unroll
        for (int ai = 0; ai < 2; ++ai)
#pragma unroll
            for (int m = 0; m < 4; ++m) { const int row = row0 + ai * 128 + m * 16; float ss = 0.f;
#pragma unroll
                for (int bj = 0; bj < 2; ++bj) { const int c = u.pn * 256 + bj * 128 + wc * 32 + 8 * fq; const size_t off = (size_t)row * 1024 + c;
                    const f32x4 x0 = *(const GAS f32x4*)(X + off), x1 = *(const GAS f32x4*)(X + off + 4);
                    const f32x4 y0 = x0 + acc[ai][bj][m][0], y1 = x1 + acc[ai][bj][m][1];
                    *(GAS f32x4*)(X1 + off) = y0; *(GAS f32x4*)(X1 + off + 4) = y1; *(GAS v4u*)(X1B + off) = pack8(y0, y1);
                    ss += (y0[0] * y0[0] + y0[1] * y0[1]) + (y0[2] * y0[2] + y0[3] * y0[3]) + (y1[0] * y1[0] + y1[1] * y1[1]) + (y1[2] * y1[2] + y1[3] * y1[3]); }
                ss += __shfl_xor(ss, 16); ss += __shfl_xor(ss, 32);
                if (fq == 0) atomicAdd(rowss + row, ss); }
    }
};
struct EpiFF1 {
    static constexpr bool PERM = true, AFTER_DRAIN = false;
    bf16* Fo; const float* rowss;
    __device__ __forceinline__ void operator()(const f32x4 (&acc)[2][2][4][2], const pg8::Unit& u, int wr, int wc, int fr, int fq) const {
        const int row0 = u.pm * 256 + wr * 64 + fr;
#pragma unroll
        for (int ai = 0; ai < 2; ++ai)
#pragma unroll
            for (int m = 0; m < 4; ++m) { const int row = row0 + ai * 128 + m * 16;
                const float rs2 = 1.0f / (rowss[row] * (1.0f / DM) + EPS);
#pragma unroll
                for (int bj = 0; bj < 2; ++bj) { const int c = u.pn * 256 + bj * 128 + wc * 32 + 8 * fq;
                    f32x4 v0 = acc[ai][bj][m][0], v1 = acc[ai][bj][m][1];
#pragma unroll
                    for (int q = 0; q < 4; ++q) { const float a = fmaxf(v0[q], 0.f), b = fmaxf(v1[q], 0.f); v0[q] = a * a * rs2; v1[q] = b * b * rs2; }
                    *(GAS v4u*)(Fo + (size_t)row * FF + c) = pack8(v0, v1); } }
    }
};
struct EpiFF2 {
    static constexpr bool PERM = true, AFTER_DRAIN = false;
    float* X1;
    __device__ __forceinline__ void operator()(const f32x4 (&acc)[2][2][4][2], const pg8::Unit& u, int wr, int wc, int fr, int fq) const {
        const int row0 = u.pm * 256 + wr * 64 + fr;
#pragma unroll
        for (int ai = 0; ai < 2; ++ai)
#pragma unroll
            for (int m = 0; m < 4; ++m) { const int row = row0 + ai * 128 + m * 16;
#pragma unroll
                for (int bj = 0; bj < 2; ++bj) { const int c = u.pn * 256 + bj * 128 + wc * 32 + 8 * fq; GAS f32x4* p = (GAS f32x4*)(X1 + (size_t)row * 1024 + c);
                    p[0] = p[0] + acc[ai][bj][m][0]; p[1] = p[1] + acc[ai][bj][m][1]; } }
    }
};

namespace att {
typedef short v4i16_t __attribute__((ext_vector_type(4)));
constexpr int NSLOT = 4, L_K0 = 0, L_K1 = 8192, L_V0 = 32768, L_V1 = 40960;
constexpr int L_TR = 65536, L_EM = 69632, L_TC = 70144, L_WMASK = 72704, L_DONE = 72768;
constexpr float THR = 8.0f;
constexpr int L_CA = 0, L_HID = 69632;
__device__ __forceinline__ int crow(int r, int hi) { return (r & 3) + 8 * (r >> 2) + 4 * hi; }
__device__ __forceinline__ s16x4 vtr(const LAS unsigned char* p) { return __builtin_bit_cast(s16x4, __builtin_amdgcn_ds_read_tr16_b64_v4i16((LAS v4i16_t*)p)); }
__device__ __forceinline__ float swapmax(float v) { auto rr = __builtin_amdgcn_permlane32_swap(__float_as_uint(v), __float_as_uint(v), false, false); return fmaxf(__uint_as_float(rr[0]), __uint_as_float(rr[1])); }
__device__ __forceinline__ float swapsum(float v) { auto rr = __builtin_amdgcn_permlane32_swap(__float_as_uint(v), __float_as_uint(v), false, false); return __uint_as_float(rr[0]) + __uint_as_float(rr[1]); }

__device__ __forceinline__ v4u ld_piece(const bf16* g, int tid) { return *(const GAS v4u*)((const GAS char*)g + tid * 16); }
__device__ __forceinline__ void st_kimg(LAS unsigned char* K, int tid, v4u v) { const int key = tid >> 3, ch = tid & 7; *(LAS v4u*)(K + ch * 1024 + key * 16) = v; }
__device__ __forceinline__ void st_vimg(LAS unsigned char* V, int tid, v4u v) { const int key = tid >> 3, c8 = tid & 7; *(LAS v4u*)(V + ((c8 >> 2) * 4 + (key >> 4)) * 1024 + (key & 15) * 64 + (c8 & 3) * 16) = v; }

__device__ __forceinline__ void glds16(const void* gsrc, unsigned lds_dst) { unsigned keep;
    asm volatile("s_mov_b32 %0, m0\n\ts_mov_b32 m0, %2\n\ts_nop 0\n\tglobal_load_lds_dwordx4 %1, off\n\ts_mov_b32 m0, %0" : "=&s"(keep) : "v"(gsrc), "s"(lds_dst) : "memory"); }
__device__ __forceinline__ void dma_kv(const bf16* kg, const bf16* vg, unsigned kdst, unsigned vdst, int lane, int w) {
    glds16(kg + lane * 64 + w * 8, (unsigned)__builtin_amdgcn_readfirstlane((int)kdst));
    glds16(vg + (16 * (w & 3) + (lane >> 2)) * 64 + (w >> 2) * 32 + (lane & 3) * 8, (unsigned)__builtin_amdgcn_readfirstlane((int)vdst));
}
#define WAITBAR(N) asm volatile("s_waitcnt vmcnt(" #N ") lgkmcnt(0)\n\ts_barrier" ::: "memory")
__device__ __forceinline__ void qkt(f32x16& p0, f32x16& p1, const LAS unsigned char* Kimg, const bf16x8 (&qr)[4], int r32, int hi) {
    const LAS unsigned char* kb = Kimg + hi * 1024 + r32 * 16;
    f32x16 a = {}, b = {};
#pragma unroll
    for (int d0 = 0; d0 < 4; ++d0) {
        const bf16x8 k0 = *(const LAS bf16x8*)(kb + d0 * 2048);
        const bf16x8 k1 = *(const LAS bf16x8*)(kb + d0 * 2048 + 512);
        a = __builtin_amdgcn_mfma_f32_32x32x16_bf16(k0, qr[d0], a, 0, 0, 0);
        b = __builtin_amdgcn_mfma_f32_32x32x16_bf16(k1, qr[d0], b, 0, 0, 0);
    }
    p0 = a; p1 = b;
}
__device__ __forceinline__ void pv(f32x16 (&o)[2], const LAS unsigned char* Vimg, int lane, const f32x16& p0, const f32x16& p1) {
    const int hi = lane >> 5;
    const LAS unsigned char* vb = Vimg + ((lane >> 4) & 1) * 32 + (lane & 3) * 8 + (4 * hi + ((lane & 15) >> 2)) * 64;
    bf16x8 pa[4];
    { v4u w;
      w.x = cvtpk(p0[0], p0[1]); w.y = cvtpk(p0[2], p0[3]); w.z = cvtpk(p0[4], p0[5]); w.w = cvtpk(p0[6], p0[7]); pa[0] = __builtin_bit_cast(bf16x8, w);
      w.x = cvtpk(p0[8], p0[9]); w.y = cvtpk(p0[10], p0[11]); w.z = cvtpk(p0[12], p0[13]); w.w = cvtpk(p0[14], p0[15]); pa[1] = __builtin_bit_cast(bf16x8, w);
      w.x = cvtpk(p1[0], p1[1]); w.y = cvtpk(p1[2], p1[3]); w.z = cvtpk(p1[4], p1[5]); w.w = cvtpk(p1[6], p1[7]); pa[2] = __builtin_bit_cast(bf16x8, w);
      w.x = cvtpk(p1[8], p1[9]); w.y = cvtpk(p1[10], p1[11]); w.z = cvtpk(p1[12], p1[13]); w.w = cvtpk(p1[14], p1[15]); pa[3] = __builtin_bit_cast(bf16x8, w); }
#pragma unroll
    for (int dh = 0; dh < 2; ++dh)
#pragma unroll
        for (int ks = 0; ks < 4; ++ks) {
            const s16x4 lo = vtr(vb + dh * 4096 + ks * 1024), hh = vtr(vb + dh * 4096 + ks * 1024 + 512);
            const bf16x8 vf = (bf16x8){lo[0], lo[1], lo[2], lo[3], hh[0], hh[1], hh[2], hh[3]};
            o[dh] = __builtin_amdgcn_mfma_f32_32x32x16_bf16(vf, pa[ks], o[dh], 0, 0, 0);
        }
}
__device__ __forceinline__ float max3f(float a, float b, float c) { float r; asm("v_max3_f32 %0, %1, %2, %3" : "=v"(r) : "v"(a), "v"(b), "v"(c)); return r; }
__device__ __forceinline__ float max2f(float a, float b) { float r; asm("v_max_f32_e32 %0, %1, %2" : "=v"(r) : "v"(a), "v"(b)); return r; }
__device__ __forceinline__ void qkt_c(f32x16& p0, f32x16& p1, const LAS unsigned char* Kimg, const bf16x8 (&qr)[4], int r32, int hi, const f32x16& c) {
    const LAS unsigned char* kb = Kimg + hi * 1024 + r32 * 16;
    f32x16 a = c, b = c;
#pragma unroll
    for (int d0 = 0; d0 < 4; ++d0) {
        const bf16x8 k0 = *(const LAS bf16x8*)(kb + d0 * 2048);
        const bf16x8 k1 = *(const LAS bf16x8*)(kb + d0 * 2048 + 512);
        a = __builtin_amdgcn_mfma_f32_32x32x16_bf16(k0, qr[d0], a, 0, 0, 0);
        b = __builtin_amdgcn_mfma_f32_32x32x16_bf16(k1, qr[d0], b, 0, 0, 0);
    }
    p0 = a; p1 = b;
}
__device__ __forceinline__ void pv_m(f32x16 (&o)[2], const LAS unsigned char* Vimg, int lane, const f32x16& p0, const f32x16& p1, unsigned amask) {
    const int hi = lane >> 5;
    const LAS unsigned char* vb = Vimg + ((lane >> 4) & 1) * 32 + (lane & 3) * 8 + (4 * hi + ((lane & 15) >> 2)) * 64;
    bf16x8 pa[4];
    { v4u w;
      w.x = cvtpk(p0[0], p0[1]) & amask; w.y = cvtpk(p0[2], p0[3]) & amask; w.z = cvtpk(p0[4], p0[5]) & amask; w.w = cvtpk(p0[6], p0[7]) & amask; pa[0] = __builtin_bit_cast(bf16x8, w);
      w.x = cvtpk(p0[8], p0[9]) & amask; w.y = cvtpk(p0[10], p0[11]) & amask; w.z = cvtpk(p0[12], p0[13]) & amask; w.w = cvtpk(p0[14], p0[15]) & amask; pa[1] = __builtin_bit_cast(bf16x8, w);
      w.x = cvtpk(p1[0], p1[1]) & amask; w.y = cvtpk(p1[2], p1[3]) & amask; w.z = cvtpk(p1[4], p1[5]) & amask; w.w = cvtpk(p1[6], p1[7]) & amask; pa[2] = __builtin_bit_cast(bf16x8, w);
      w.x = cvtpk(p1[8], p1[9]) & amask; w.y = cvtpk(p1[10], p1[11]) & amask; w.z = cvtpk(p1[12], p1[13]) & amask; w.w = cvtpk(p1[14], p1[15]) & amask; pa[3] = __builtin_bit_cast(bf16x8, w); }
#pragma unroll
    for (int dh = 0; dh < 2; ++dh)
#pragma unroll
        for (int ks = 0; ks < 4; ++ks) {
            const s16x4 lo = vtr(vb + dh * 4096 + ks * 1024), hh = vtr(vb + dh * 4096 + ks * 1024 + 512);
            const bf16x8 vf = (bf16x8){lo[0], lo[1], lo[2], lo[3], hh[0], hh[1], hh[2], hh[3]};
            o[dh] = __builtin_amdgcn_mfma_f32_32x32x16_bf16(vf, pa[ks], o[dh], 0, 0, 0);
        }
}
#define SBAR() __builtin_amdgcn_sched_barrier(0)
__device__ __forceinline__ void kload8(bf16x8 (&kf)[8], const LAS unsigned char* Kimg, int r32, int hi) {
    const LAS unsigned char* kb = Kimg + hi * 1024 + r32 * 16;
#pragma unroll
    for (int d0 = 0; d0 < 4; ++d0) { kf[2 * d0] = *(const LAS bf16x8*)(kb + d0 * 2048); kf[2 * d0 + 1] = *(const LAS bf16x8*)(kb + d0 * 2048 + 512); }
}
__device__ __forceinline__ void qk_mma(f32x16& p0, f32x16& p1, const bf16x8 (&kf)[8], const bf16x8 (&qr)[4], const f32x16& c) {
    f32x16 a = c, b = c;
#pragma unroll
    for (int d0 = 0; d0 < 4; ++d0) { a = __builtin_amdgcn_mfma_f32_32x32x16_bf16(kf[2 * d0], qr[d0], a, 0, 0, 0); b = __builtin_amdgcn_mfma_f32_32x32x16_bf16(kf[2 * d0 + 1], qr[d0], b, 0, 0, 0); }
    p0 = a; p1 = b;
}
__device__ __forceinline__ void vload8(bf16x8 (&vf)[8], const LAS unsigned char* Vimg, int lane) {
    const int hi = lane >> 5;
    const LAS unsigned char* vb = Vimg + ((lane >> 4) & 1) * 32 + (lane & 3) * 8 + (4 * hi + ((lane & 15) >> 2)) * 64;
#pragma unroll
    for (int i = 0; i < 8; ++i) { const s16x4 lo = vtr(vb + (i >> 2) * 4096 + (i & 3) * 1024), hh = vtr(vb + (i >> 2) * 4096 + (i & 3) * 1024 + 512);
        vf[i] = (bf16x8){lo[0], lo[1], lo[2], lo[3], hh[0], hh[1], hh[2], hh[3]}; }
}
__device__ __forceinline__ void pv_mma(f32x16 (&o)[2], const bf16x8 (&vf)[8], const f32x16& p0, const f32x16& p1, unsigned amask) {
    bf16x8 pa[4];
    { v4u w;
      w.x = cvtpk(p0[0], p0[1]) & amask; w.y = cvtpk(p0[2], p0[3]) & amask; w.z = cvtpk(p0[4], p0[5]) & amask; w.w = cvtpk(p0[6], p0[7]) & amask; pa[0] = __builtin_bit_cast(bf16x8, w);
      w.x = cvtpk(p0[8], p0[9]) & amask; w.y = cvtpk(p0[10], p0[11]) & amask; w.z = cvtpk(p0[12], p0[13]) & amask; w.w = cvtpk(p0[14], p0[15]) & amask; pa[1] = __builtin_bit_cast(bf16x8, w);
      w.x = cvtpk(p1[0], p1[1]) & amask; w.y = cvtpk(p1[2], p1[3]) & amask; w.z = cvtpk(p1[4], p1[5]) & amask; w.w = cvtpk(p1[6], p1[7]) & amask; pa[2] = __builtin_bit_cast(bf16x8, w);
      w.x = cvtpk(p1[8], p1[9]) & amask; w.y = cvtpk(p1[10], p1[11]) & amask; w.z = cvtpk(p1[12], p1[13]) & amask; w.w = cvtpk(p1[14], p1[15]) & amask; pa[3] = __builtin_bit_cast(bf16x8, w); }
#pragma unroll
    for (int ks = 0; ks < 4; ++ks) { o[0] = __builtin_amdgcn_mfma_f32_32x32x16_bf16(vf[ks], pa[ks], o[0], 0, 0, 0); o[1] = __builtin_amdgcn_mfma_f32_32x32x16_bf16(vf[4 + ks], pa[ks], o[1], 0, 0, 0); }
}
struct SM {
    float mref, l; bool started; f32x16 negm; f32x16 o[2];
    __device__ __forceinline__ void reset() { mref = 0.f; l = 0.f; started = false; negm = f32x16{}; o[0] = f32x16{}; o[1] = f32x16{}; }
};
template <int BIAS>
__device__ __forceinline__ void sm_tile(SM& S, const LAS unsigned char* Kimg, const LAS unsigned char* Vimg, const bf16x8 (&qr)[4], int lane, const LAS float* tb, bool active) {
    const int r32 = lane & 31, hi = lane >> 5;
    bf16x8 kf[8]; kload8(kf, Kimg, r32, hi); SBAR();
    f32x16 p0, p1; qk_mma(p0, p1, kf, qr, S.negm);
    bf16x8 vf[8]; vload8(vf, Vimg, lane); SBAR();
    if (BIAS) {
#pragma unroll
        for (int r = 0; r < 16; ++r) { p0[r] += tb[(r & 3) + 8 * (r >> 2)]; p1[r] += tb[32 + (r & 3) + 8 * (r >> 2)]; }
    } else asm volatile("s_nop 15\n\ts_nop 7" : "+v"(p0), "+v"(p1));
    float a = max3f(p0[0], p0[1], p1[0]), b = max3f(p0[2], p0[3], p1[1]); a = max3f(a, p1[2], p1[3]);
#pragma unroll
    for (int r = 4; r < 16; r += 4) { a = max3f(a, p0[r], p0[r + 1]); b = max3f(b, p0[r + 2], p0[r + 3]); a = max3f(a, p1[r], p1[r + 1]); b = max3f(b, p1[r + 2], p1[r + 3]); }
    float rm = swapmax(max2f(a, b));
    if (!active) rm = NEGBIG;
    const bool need = S.started ? (rm > THR) : (rm > -1e29f);
    if (__any(need)) {
        const float dl = need ? rm : 0.f;
        const float f = S.started ? fast_exp2(-dl) : 1.0f;
        S.mref += dl; S.started = S.started || need; S.l *= f;
#pragma unroll
        for (int r = 0; r < 16; ++r) { p0[r] -= dl; p1[r] -= dl; S.o[0][r] *= f; S.o[1][r] *= f; S.negm[r] = -S.mref; }
    }
    float s = 0.f;
#pragma unroll
    for (int r = 0; r < 16; ++r) { p0[r] = fast_exp2(p0[r]); p1[r] = fast_exp2(p1[r]); s += p0[r] + p1[r]; }
    S.l += active ? s : 0.f;
    pv_mma(S.o, vf, p0, p1, active ? 0xffffffffu : 0u);
}
__device__ __forceinline__ void acc_out(f32x16 (&oacc)[2], const f32x16 (&o)[2], float sc) {
#pragma unroll
    for (int r = 0; r < 16; ++r) { oacc[0][r] += o[0][r] * sc; oacc[1][r] += o[1][r] * sc; }
}
__device__ __forceinline__ void store_o(bf16* dst, const f32x16 (&o)[2], int hi) {
#pragma unroll
    for (int dh = 0; dh < 2; ++dh)
#pragma unroll
        for (int i = 0; i < 4; ++i) { v2u w; w.x = cvtpk(o[dh][4 * i], o[dh][4 * i + 1]); w.y = cvtpk(o[dh][4 * i + 2], o[dh][4 * i + 3]);
            *(GAS v2u*)(dst + 32 * dh + 8 * i + 4 * hi) = w; }
}
struct TileIter {
    unsigned um; int j, jt0, kind, n;
    __device__ __forceinline__ void init(unsigned um_, int j_) { um = um_; j = j_; jt0 = j_ >= 8 ? j_ - 8 : 0; kind = 0; n = -1; }
    __device__ __forceinline__ bool advance() {
        if (kind == 0) { const unsigned rest = (n >= 31) ? 0u : ((um >> (n + 1)) << (n + 1));
            if (rest) { n = __builtin_ctz(rest); return true; }
            kind = 1; n = jt0; return true; }
        ++n; return n <= j;
    }
};

__device__ __forceinline__ void nsa_unit(Frame& F, unsigned char* ws, const float* rel_bias, int b, int g, int j) {
    LAS unsigned char* lds = F.lds;
    int tid = F.tid; asm volatile("" : "+v"(tid));
    const int lane = tid & 63, w = F.wave, r32 = lane & 31, hi = lane >> 5;
    const int tl = r32 >> 2, hd = r32 & 3, tokl = 8 * w + tl, t = 64 * j + tokl, head = 4 * g + hd;
    const size_t row = (size_t)b * SEQ + t;
    const bf16* QN = (const bf16*)(ws + WS_QN); const bf16* KV = (const bf16*)(ws + WS_KV); const float* GN = (const float*)(ws + WS_GN);
    LAS float* TR = (LAS float*)(lds + L_TR); LAS float* EM = (LAS float*)(lds + L_EM); LAS float* TC = (LAS float*)(lds + L_TC); LAS unsigned* wmask = (LAS unsigned*)(lds + L_WMASK);
    const bool two = j >= 16;
    __syncthreads();
    for (int i = tid; i < 4 * 256; i += 512) { const int h = i >> 8, dist = 191 - (i & 255);
        TR[i] = dist < 0 ? NEGBIG : (dist < 128 ? (rel_bias[T5B[dist] * 8 + 4 * g + h] - rel_bias[31 * 8 + 4 * g + h]) * LOG2E : 0.f); }
    if (tid < 128) EM[tid] = tid > 63 ? 0.f : NEGBIG;
    for (int i = tid; i < 4 * 129; i += 512) { const int h = i / 129, d = i % 129; TC[h * 132 + d] = (rel_bias[T5B[d] * 8 + 4 * g + h] - rel_bias[31 * 8 + 4 * g + h]) * LOG2E; }
    { const bf16* kc = (const bf16*)(ws + WS_KC) + (size_t)(b * 2 + g) * 128 * 64; const bf16* vc = (const bf16*)(ws + WS_VC) + (size_t)(b * 2 + g) * 128 * 64;
      const v4u a0 = ld_piece(kc, tid), c0 = ld_piece(vc, tid); st_kimg(lds + L_K0, tid, a0); st_vimg(lds + L_V0, tid, c0);
      if (two) { const v4u a1 = ld_piece(kc + 4096, tid), c1 = ld_piece(vc + 4096, tid); st_kimg(lds + L_K1, tid, a1); st_vimg(lds + L_V1, tid, c1); } }
    bf16x8 qr[4];
    { const bf16* qp = QN + row * 512 + head * 64;
#pragma unroll
      for (int d0 = 0; d0 < 4; ++d0) qr[d0] = *(const GAS bf16x8*)(qp + 16 * d0 + 8 * hi); }
    const float g_cmp = GN[row * 24 + head * 3 + 0], g_sel = GN[row * 24 + head * 3 + 1], g_win = GN[row * 24 + head * 3 + 2];
    __syncthreads();
    f32x16 oacc[2]; oacc[0] = f32x16{}; oacc[1] = f32x16{};
    unsigned mymask = 1u | (1u << j);
    {
        f32x16 s[4];
        qkt(s[0], s[1], lds + L_K0, qr, r32, hi);
        if (two) qkt(s[2], s[3], lds + L_K1, qr, r32, hi); else { s[2] = f32x16{}; s[3] = f32x16{}; }
        const LAS float* tc = TC + hd * 132;
        const int dbase = t - 31 - 64 * hi;
        float mx = NEGBIG;
#pragma unroll
        for (int q = 0; q < 4; ++q) {
            if (32 * q + 31 <= 4 * j - 10) {
#pragma unroll
                for (int r = 0; r < 16; ++r) mx = fmaxf(mx, s[q][r]);
            } else if (32 * q > 4 * j + 2) {
#pragma unroll
                for (int r = 0; r < 16; ++r) s[q][r] = NEGBIG;
            } else {
#pragma unroll
                for (int r = 0; r < 16; ++r) { const int dist = dbase - 16 * (32 * q + (r & 3) + 8 * (r >> 2));
                    const int di = dist < 0 ? 0 : (dist > 128 ? 128 : dist);
                    const float v = dist >= 0 ? s[q][r] + tc[di] : NEGBIG; s[q][r] = v; mx = fmaxf(mx, v); }
            }
        }
        mx = swapmax(mx);
        const bool anyv = mx > -1e29f;
        const float sub = anyv ? mx : 1e30f;
        float sum = 0.f;
#pragma unroll
        for (int q = 0; q < 4; ++q)
#pragma unroll
            for (int r = 0; r < 16; ++r) { const float p = fast_exp2(s[q][r] - sub); s[q][r] = p; sum += p; }
        sum = swapsum(sum);
        const float inv = anyv ? 1.0f / sum : 0.f;
#pragma unroll
        for (int q = 0; q < 4; ++q)
#pragma unroll
            for (int r = 0; r < 16; ++r) s[q][r] *= inv;
        float val[16];
#pragma unroll
        for (int q = 0; q < 4; ++q)
#pragma unroll
            for (int i = 0; i < 4; ++i) val[4 * q + i] = (s[q][4 * i] + s[q][4 * i + 1]) + (s[q][4 * i + 2] + s[q][4 * i + 3]);
#pragma unroll
        for (int u = 0; u < 16; ++u) {
            const float lastu = s[u >> 2][4 * (u & 3) + 3];
            auto rr = __builtin_amdgcn_permlane32_swap(__float_as_uint(lastu), __float_as_uint(lastu), false, false);
            if (hi) val[u] += __uint_as_float(rr[0]); else if (u + 1 < 16) val[u + 1] += __uint_as_float(rr[1]);
        }
#pragma unroll
        for (int u = 0; u < 16; ++u) { val[u] += __shfl_xor(val[u], 1); val[u] += __shfl_xor(val[u], 2); }
        {
            unsigned b1 = 0u, b2 = 0u;
#pragma unroll
            for (int u = 0; u < 16; ++u) { const int n = 2 * u + hi; const unsigned key = (n >= 1 && n < j) ? ((__float_as_uint(val[u]) & ~31u) | (unsigned)(31 - n)) : 0u;
                const unsigned lo = b1 < key ? b1 : key; b1 = b1 < key ? key : b1; b2 = b2 < lo ? lo : b2; }
            auto ra = __builtin_amdgcn_permlane32_swap(b1, b1, false, false); auto rb = __builtin_amdgcn_permlane32_swap(b2, b2, false, false);
            const unsigned a1 = ra[0], c1 = ra[1], a2 = rb[0], c2 = rb[1];
            const unsigned t1 = a1 > c1 ? a1 : c1, lo1 = a1 > c1 ? c1 : a1, hi2 = a2 > c2 ? a2 : c2, t2 = lo1 > hi2 ? lo1 : hi2;
            if (t1) mymask |= 1u << (31 - (t1 & 31u));
            if (t2) mymask |= 1u << (31 - (t2 & 31u));
        }
        f32x16 o[2]; o[0] = f32x16{}; o[1] = f32x16{};
        pv(o, lds + L_V0, lane, s[0], s[1]);
        if (two) pv(o, lds + L_V1, lane, s[2], s[3]);
        acc_out(oacc, o, g_cmp);
    }
    unsigned wm = mymask;
#pragma unroll
    for (int o_ = 1; o_ < 64; o_ <<= 1) wm |= (unsigned)__shfl_xor((int)wm, o_);
    if (lane == 0) wmask[w] = wm;
    __syncthreads();
    unsigned um = 0;
#pragma unroll
    for (int i = 0; i < 8; ++i) um |= wmask[i];
    um = (unsigned)__builtin_amdgcn_readfirstlane((int)um);
    wm = (unsigned)__builtin_amdgcn_readfirstlane((int)wm);
    {
        const size_t slab = (size_t)(b * 2 + g) * SEQ * 64;
        const bf16* ks = KV + 2 * KVARR + slab; const bf16* vs = KV + 3 * KVARR + slab; const bf16* kw = KV + 4 * KVARR + slab; const bf16* vw = KV + 5 * KVARR + slab;
        SM S; S.reset();
        const LAS float* trb = TR + hd * 256 + 191 - (tokl - 4 * hi);
        const LAS float* emb = EM + 63 - (tokl - 4 * hi);
        const int nsel = __builtin_popcount(um), ntile = nsel + (j >= 8 ? 9 : j + 1);
        const unsigned ldsb = (unsigned)(size_t)lds;
        const unsigned kdst0 = ldsb + L_K0 + w * 1024, vdst0 = ldsb + L_V0 + w * 1024;
        TileIter isu; isu.init(um, j); int issued = 0;
#define NSA_ISSUE() do { isu.advance(); const int sl_ = issued & (NSLOT - 1); \
        dma_kv((isu.kind ? kw : ks) + (size_t)isu.n * 4096, (isu.kind ? vw : vs) + (size_t)isu.n * 4096, kdst0 + sl_ * 8192, vdst0 + sl_ * 8192, lane, w); ++issued; } while (0)
        asm volatile("s_waitcnt vmcnt(0)" ::: "memory");
        for (int k = 0; k < NSLOT - 1; ++k) if (issued < ntile) NSA_ISSUE();
        TileIter cur; cur.init(um, j);
        for (int i = 0; i < ntile; ++i) {
            cur.advance();
            const int ahead = issued - i - 1;
            if (ahead >= 2) WAITBAR(4); else if (ahead == 1) WAITBAR(2); else WAITBAR(0);
            if (issued < ntile) NSA_ISSUE();
            const LAS unsigned char* Kb = lds + L_K0 + (i & (NSLOT - 1)) * 8192; const LAS unsigned char* Vb = lds + L_V0 + (i & (NSLOT - 1)) * 8192;
            const int n = cur.n, dj = j - n;
            if (cur.kind == 0) {
                if ((wm >> n) & 1u) {
                    const bool sel = (mymask >> n) & 1u;
                    if (dj >= 3) sm_tile<0>(S, Kb, Vb, qr, lane, trb, sel);
                    else sm_tile<1>(S, Kb, Vb, qr, lane, trb - 64 * dj, sel);
                }
                if (i + 1 == nsel) {
                    const float l = swapsum(S.l); acc_out(oacc, S.o, g_sel / l);
                    S.reset();
                }
            } else {
                if (dj >= 3 && dj < 8) sm_tile<0>(S, Kb, Vb, qr, lane, trb, true);
                else if (dj == 8) sm_tile<1>(S, Kb, Vb, qr, lane, emb, true);
                else sm_tile<1>(S, Kb, Vb, qr, lane, trb - 64 * dj, true);
            }
        }
#undef NSA_ISSUE
        const float l = swapsum(S.l);
        acc_out(oacc, S.o, g_win / l);
    }
    store_o((bf16*)(ws + WS_ONSA) + row * 512 + head * 64, oacc, hi);
}

__device__ __forceinline__ void sb_unit(Frame& F, unsigned char* ws, int b, int h, int qb) {
    LAS unsigned char* lds = F.lds;
    int tid = F.tid; asm volatile("" : "+v"(tid));
    const int lane = tid & 63, w = F.wave, r32 = lane & 31, hi = lane >> 5;
    const int t = 256 * qb + 32 * w + r32;
    const bf16* SBQ = (const bf16*)(ws + WS_SB) + (size_t)(b * 8 + h) * SEQ * 64; const bf16* SBK = SBQ + SBARR; const bf16* SBV = SBQ + 2 * SBARR;
    LAS unsigned* donef = (LAS unsigned*)(lds + L_DONE);
    bf16x8 qr[4];
#pragma unroll
    for (int d0 = 0; d0 < 4; ++d0) qr[d0] = *(const GAS bf16x8*)(SBQ + (size_t)t * 64 + 16 * d0 + 8 * hi);
    f32x16 o[2]; o[0] = f32x16{}; o[1] = f32x16{};
    float C = 0.f;
    bool done = false;
    const int ktop = 4 * qb + 3, kmine = 4 * qb + (w >> 1);
    __syncthreads();
    const unsigned ldsb = (unsigned)(size_t)lds;
    const unsigned kdst0 = ldsb + L_K0 + w * 1024, vdst0 = ldsb + L_V0 + w * 1024;
    asm volatile("s_waitcnt vmcnt(0)" ::: "memory");
    int issued = 0;
#define SB_ISSUE() do { const int kt_ = ktop - issued, sl_ = issued & (NSLOT - 1); \
        dma_kv(SBK + (size_t)kt_ * 4096, SBV + (size_t)kt_ * 4096, kdst0 + sl_ * 8192, vdst0 + sl_ * 8192, lane, w); ++issued; } while (0)
    for (int k = 0; k < NSLOT - 1; ++k) if (issued <= ktop) SB_ISSUE();
    for (int kt = ktop, i = 0; kt >= 0; --kt, ++i) {
        if (lane == 0) donef[(i & 1) * 8 + w] = done ? 1u : 0u;
        const int ahead = issued - i - 1;
        if (ahead >= 2) WAITBAR(4); else if (ahead == 1) WAITBAR(2); else WAITBAR(0);
        unsigned nd = 0;
#pragma unroll
        for (int q = 0; q < 8; ++q) nd += donef[(i & 1) * 8 + q];
        if (__builtin_amdgcn_readfirstlane((int)nd) == 8) break;
        if (issued <= ktop) SB_ISSUE();
        const LAS unsigned char* Kb = lds + L_K0 + (i & (NSLOT - 1)) * 8192; const LAS unsigned char* Vb = lds + L_V0 + (i & (NSLOT - 1)) * 8192;
        if (done || kt > kmine) continue;
        bf16x8 kf[8]; kload8(kf, Kb, r32, hi); SBAR();
        f32x16 z0, z1; { const f32x16 zc = {}; qk_mma(z0, z1, kf, qr, zc); }
        bf16x8 vf[8]; vload8(vf, Vb, lane); SBAR();
        const int kb0 = 64 * kt + 4 * hi;
        f32x16 lb0, lb1;
        if (kt == kmine) {
#pragma unroll
            for (int r = 0; r < 16; ++r) {
                { const float z = z0[r], e = fast_exp2(-fabsf(z)), L = __builtin_amdgcn_logf(1.0f + e); const bool ok = kb0 + (r & 3) + 8 * (r >> 2) < t;
                  lb0[r] = ok ? fminf(z, 0.f) - L : NEGBIG; z0[r] = ok ? -fmaxf(z, 0.f) - L : 0.f; }
                { const float z = z1[r], e = fast_exp2(-fabsf(z)), L = __builtin_amdgcn_logf(1.0f + e); const bool ok = kb0 + 32 + (r & 3) + 8 * (r >> 2) < t;
                  lb1[r] = ok ? fminf(z, 0.f) - L : NEGBIG; z1[r] = ok ? -fmaxf(z, 0.f) - L : 0.f; }
            }
        } else {
#pragma unroll
            for (int r = 0; r < 16; ++r) {
                { const float z = z0[r], e = fast_exp2(-fabsf(z)), L = __builtin_amdgcn_logf(1.0f + e); lb0[r] = fminf(z, 0.f) - L; z0[r] = -fmaxf(z, 0.f) - L; }
                { const float z = z1[r], e = fast_exp2(-fabsf(z)), L = __builtin_amdgcn_logf(1.0f + e); lb1[r] = fminf(z, 0.f) - L; z1[r] = -fmaxf(z, 0.f) - L; }
            }
        }
        float gs[8];
#pragma unroll
        for (int i = 0; i < 4; ++i) { gs[i] = (z0[4 * i] + z0[4 * i + 1]) + (z0[4 * i + 2] + z0[4 * i + 3]); gs[4 + i] = (z1[4 * i] + z1[4 * i + 1]) + (z1[4 * i + 2] + z1[4 * i + 3]); }
        float E[8]; float run = 0.f;
#pragma unroll
        for (int u = 7; u >= 0; --u) {
            auto rr = __builtin_amdgcn_permlane32_swap(__float_as_uint(gs[u]), __float_as_uint(gs[u]), false, false);
            const float g0 = __uint_as_float(rr[0]), g1 = __uint_as_float(rr[1]);
            const float e1 = run; run += g1; const float e0 = run; run += g0;
            E[u] = hi ? e1 : e0;
        }
#pragma unroll
        for (int i = 0; i < 4; ++i) {
            { float later = C + E[i];
              const float a3 = fast_exp2(lb0[4 * i + 3] + later); later += z0[4 * i + 3];
              const float a2 = fast_exp2(lb0[4 * i + 2] + later); later += z0[4 * i + 2];
              const float a1 = fast_exp2(lb0[4 * i + 1] + later); later += z0[4 * i + 1];
              const float a0 = fast_exp2(lb0[4 * i] + later);
              z0[4 * i] = a0; z0[4 * i + 1] = a1; z0[4 * i + 2] = a2; z0[4 * i + 3] = a3; }
            { float later = C + E[4 + i];
              const float a3 = fast_exp2(lb1[4 * i + 3] + later); later += z1[4 * i + 3];
              const float a2 = fast_exp2(lb1[4 * i + 2] + later); later += z1[4 * i + 2];
              const float a1 = fast_exp2(lb1[4 * i + 1] + later); later += z1[4 * i + 1];
              const float a0 = fast_exp2(lb1[4 * i] + later);
              z1[4 * i] = a0; z1[4 * i + 1] = a1; z1[4 * i + 2] = a2; z1[4 * i + 3] = a3; }
        }
        C += run;
        pv_mma(o, vf, z0, z1, 0xffffffffu);
        done = __all(C < -151.0f);
    }
#undef SB_ISSUE
    asm volatile("s_waitcnt vmcnt(0)" ::: "memory");
    store_o((bf16*)(ws + WS_OSB) + ((size_t)b * SEQ + t) * 512 + h * 64, o, hi);
}

__device__ __forceinline__ float gelu_tanh(float x) {
    const float u = 0.7978845608028654f * (x + 0.044715f * x * x * x);
    const float e = fast_exp2(2.0f * LOG2E * u);
    const float th = 1.0f - 2.0f * __builtin_amdgcn_rcpf(e + 1.0f);
    return 0.5f * x * (1.0f + th);
}
__device__ __forceinline__ void cmp_unit(Frame& F, unsigned char* ws, const float* b1, int kv, int b, int g, int cc) {
    LAS unsigned char* lds = F.lds;
    int tid = F.tid; asm volatile("" : "+v"(tid));
    const int lane = tid & 63, w = F.wave, r32 = lane & 31, hi = lane >> 5;
    const bf16* src = (const bf16*)(ws + WS_KV) + (size_t)kv * KVARR + (size_t)(b * 2 + g) * SEQ * 64 + (size_t)(512 * cc) * 64;
    const bf16* W1T = (const bf16*)(ws + (kv ? WS_CW1V : WS_CW1K)); const bf16* W2T = (const bf16*)(ws + (kv ? WS_CW2V : WS_CW2K));
    const float* b1p = (const float*)(ws + WS_B1P) + kv * 256;
    bf16* dst = (bf16*)(ws + (kv ? WS_VC : WS_KC)) + (size_t)(b * 2 + g) * 128 * 64;
    LAS bf16* hid = (LAS bf16*)(lds + L_HID);
    __syncthreads();
    for (int p = tid; p < 528 * 8; p += 512) { const int tok = p >> 3, ch = p & 7;
        const v4u v = *(const GAS v4u*)((const GAS char*)src + (size_t)p * 16);
        *(LAS v4u*)(lds + L_CA + tok * 128 + ((ch ^ ((tok >> 4) & 7)) * 16)) = v; }
    __syncthreads();
    f32x16 acc = {};
    const bf16* brow = W1T + (size_t)(32 * w + r32) * 2048 + 8 * hi;
#pragma unroll 4
    for (int ks = 0; ks < 128; ++ks) {
        const int l = ks >> 2, ch = 2 * (ks & 3) + hi, tok = 16 * r32 + l;
        const bf16x8 af = *(const LAS bf16x8*)(lds + L_CA + tok * 128 + ((ch ^ ((tok >> 4) & 7)) * 16));
        const bf16x8 bf = *(const GAS bf16x8*)(brow + 16 * ks);
        acc = __builtin_amdgcn_mfma_f32_32x32x16_bf16(af, bf, acc, 0, 0, 0);
    }
    { const float bias = b1[32 * w + r32] + b1p[32 * w + r32];
#pragma unroll
      for (int r = 0; r < 16; ++r) hid[crow(r, hi) * 264 + 32 * w + r32] = (bf16)f2bf(gelu_tanh(acc[r] + bias)); }
    __syncthreads();
    if (w < 2) {
        f32x16 o = {};
        const LAS bf16* hrow = hid + r32 * 264 + 8 * hi;
        const bf16* w2row = W2T + (size_t)(32 * w + r32) * 256 + 8 * hi;
#pragma unroll
        for (int ks = 0; ks < 16; ++ks) {
            const bf16x8 af = *(const LAS bf16x8*)(hrow + 16 * ks);
            const bf16x8 bf = *(const GAS bf16x8*)(w2row + 16 * ks);
            o = __builtin_amdgcn_mfma_f32_32x32x16_bf16(af, bf, o, 0, 0, 0);
        }
#pragma unroll
        for (int r = 0; r < 16; ++r) { const int cr = 32 * cc + crow(r, hi); dst[(size_t)cr * 64 + 32 * w + r32] = (bf16)(cr < 127 ? f2bf(o[r]) : 0u); }
    }
}
}

__device__ __forceinline__ void final_norm_row(int lane, float* xrow, const float* g) {
    GAS f32x4* xr = (GAS f32x4*)xrow + lane; const GAS f32x4* gr = (const GAS f32x4*)g + lane;
    f32x4 v[4]; float s = 0.f;
#pragma unroll
    for (int j = 0; j < 4; ++j) { v[j] = xr[64 * j]; s += (v[j].x * v[j].x + v[j].y * v[j].y) + (v[j].z * v[j].z + v[j].w * v[j].w); }
    const float rstd = 1.f / sqrtf(wave_sum(s) * (1.f / DM) + EPS);
#pragma unroll
    for (int j = 0; j < 4; ++j) { const f32x4 gg = gr[64 * j]; xr[64 * j] = v[j] * rstd * gg; }
}

struct Args { In in; float* out; unsigned char* ws; int ph_lo, ph_hi; int reps[4]; };
__global__ void __launch_bounds__(NWAVES * 64, 2) fwd_kernel(Args args) {
    extern __shared__ __attribute__((aligned(16))) unsigned char lds[];
    Frame F;
    F.lds = (LAS unsigned char*)lds;
    F.MISC = (volatile LAS unsigned*)(F.lds + MISC_OFF);
    F.tid = threadIdx.x; F.lane = F.tid & 63; F.wave = __builtin_amdgcn_readfirstlane(F.tid >> 6);
    F.G = gridDim.x; { const int bx = blockIdx.x; F.vcu = (F.G % 8 == 0) ? (bx % 8) * (F.G / 8) + bx / 8 : bx; }
    unsigned char* ws = args.ws;
    F.ctl = (gu32*)(ws + WS_CTL);
    for (int u = F.tid; u < (LDS_BYTES - LDSCTL_OFF) / 4; u += NWAVES * 64) ((LAS unsigned*)(F.lds + LDSCTL_OFF))[u] = 0u;
    __syncthreads();
    constexpr bool PER_PHASE = (MK_N_LAUNCHES != 1);
    XcdBarrier bar; bar.bar = (unsigned*)(F.ctl + CW_BAR); bar.x = 0; bar.st = nullptr;
    if (!PER_PHASE) bar = xcd_barrier_post((unsigned*)(F.ctl + CW_BAR), F.MISC + 8);
#define GRID_BAR() do { if (!PER_PHASE) xcd_barrier(bar); } while (0)
    const int lo = args.ph_lo, hi = args.ph_hi;
#define IN(k) (lo <= (k) && (k) < hi)
#define BOTH(k) (IN(k) && IN((k) + 1))
    const In& in = args.in;
    bf16* XN = (bf16*)(ws + WS_XN);

    if (IN(0)) { p0_prologue(F, in, ws); if (BOTH(0)) GRID_BAR(); }
    if (IN(1)) {
        pg8::Gemm g{XN, (const bf16*)(ws + WS_WIN), M, N1, DM}; pg8::StaticOrder S; S.init(M, N1, F.G, (int)blockIdx.x);
        EpiInProj E{(bf16*)(ws + WS_QN), (bf16*)(ws + WS_KV), (bf16*)(ws + WS_SB), (bf16*)(ws + WS_GM), (float*)(ws + WS_GN)};
        pg8::gemm_phase<EpiInProj, pg8::StaticOrder, true, true>(F.lds + RING_OFF, g, S, E);
        if (BOTH(1)) GRID_BAR();
    }
    if (IN(2)) {
        for (int rep = 0; rep < args.reps[0]; ++rep)
        for (int i = F.vcu; i < 256; i += F.G) { const int kv = i >> 7, b = (i >> 3) & 15, g = (i >> 2) & 1, cc = i & 3;
            att::cmp_unit(F, ws, kv ? in.p[10] : in.p[6], kv, b, g, cc); }
        if (BOTH(2)) GRID_BAR();
    }
    if (IN(3)) {
        for (int rep = 0; rep < args.reps[1]; ++rep)
        for (int i = F.vcu; i < 1024; i += F.G) { const int v = i & 255, k = i >> 8, bg = v >> 3, s = v & 7;
            const int j = (k == 0) ? s : (k == 1) ? 15 - s : (k == 2) ? 16 + s : 31 - s;
            att::nsa_unit(F, ws, in.p[3], bg >> 1, bg & 1, j); }
        for (int rep = 0; rep < args.reps[2]; ++rep)
        for (int i = F.vcu; i < 1024; i += F.G) { const int v = i & 255, k = i >> 8, bh = v >> 1, s = v & 1;
            const int qb = (k == 0) ? s : (k == 1) ? 3 - s : (k == 2) ? 4 + s : 7 - s;
            att::sb_unit(F, ws, bh >> 3, bh & 7, qb); }
        __syncthreads();
        if (BOTH(3)) GRID_BAR();
    }
    if (IN(4)) {
        { pg8::Gemm g{(const bf16*)(ws + WS_ONSA), (const bf16*)(ws + WS_WN), M, DM, 512}; pg8::StaticOrder S; S.init(M, DM, F.G, (int)blockIdx.x);
          EpiUp<false> E{(bf16*)(ws + WS_MIX), (const bf16*)(ws + WS_GM)};
          pg8::gemm_phase<EpiUp<false>, pg8::StaticOrder, true, true>(F.lds + RING_OFF, g, S, E); }
        asm volatile("s_waitcnt vmcnt(0)" ::: "memory"); __syncthreads();
        { pg8::Gemm g{(const bf16*)(ws + WS_OSB), (const bf16*)(ws + WS_WSB), M, DM, 512}; pg8::StaticOrder S; S.init(M, DM, F.G, (int)blockIdx.x);
          EpiUp<true> E{(bf16*)(ws + WS_MIX), (const bf16*)(ws + WS_GM) + 1024};
          pg8::gemm_phase<EpiUp<true>, pg8::StaticOrder, true, true>(F.lds + RING_OFF, g, S, E); }
        if (BOTH(4)) GRID_BAR();
    }
    if (IN(5)) {
        pg8::Gemm g{(const bf16*)(ws + WS_MIX), (const bf16*)(ws + WS_WO), M, DM, DM}; pg8::StaticOrder S; S.init(M, DM, F.G, (int)blockIdx.x);
        EpiOut E{in.p[0], args.out, (bf16*)(ws + WS_X1B), (float*)(ws + WS_ROWSS)};
        pg8::gemm_phase<EpiOut, pg8::StaticOrder, true, true>(F.lds + RING_OFF, g, S, E);
        if (BOTH(5)) GRID_BAR();
    }
    if (IN(6)) {
        pg8::Gemm g{(const bf16*)(ws + WS_X1B), (const bf16*)(ws + WS_W1), M, FF, DM}; pg8::StaticOrder S; S.init(M, FF, F.G, (int)blockIdx.x);
        EpiFF1 E{(bf16*)(ws + WS_F), (const float*)(ws + WS_ROWSS)};
        pg8::gemm_phase<EpiFF1, pg8::StaticOrder, true, true>(F.lds + RING_OFF, g, S, E);
        if (BOTH(6)) GRID_BAR();
    }
    if (IN(7)) {
        pg8::Gemm g{(const bf16*)(ws + WS_F), (const bf16*)(ws + WS_W2), M, DM, FF}; pg8::StaticOrder S; S.init(M, DM, F.G, (int)blockIdx.x);
        EpiFF2 E{args.out};
        pg8::gemm_phase<EpiFF2, pg8::StaticOrder, true, true>(F.lds + RING_OFF, g, S, E);
        if (BOTH(7)) GRID_BAR();
    }
    if (IN(8)) {
        const int gw = F.vcu * NWAVES + F.wave, NGW = F.G * NWAVES;
        const int lane8 = (int)__builtin_amdgcn_mbcnt_hi(~0u, __builtin_amdgcn_mbcnt_lo(~0u, 0u));
        for (int m = gw; m < M; m += NGW) final_norm_row(lane8, args.out + (size_t)m * DM, in.p[18]);
    }
#undef IN
#undef BOTH
}

extern "C" void kernel_launch(void* const* d_in, const int* in_sizes, int n_in, void* d_out, int out_size, void* d_ws, size_t ws_size, hipStream_t stream) {
    static int grid = 0;
    if (grid == 0) {
        if (n_in != 19 || in_sizes[0] != M * DM || out_size != M * DM || ws_size < WS_END) { fprintf(stderr, "kernel_launch: unexpected shapes (n_in %d, in0 %d, out %d, ws %zu); nothing launched\n", n_in, n_in > 0 ? in_sizes[0] : -1, out_size, ws_size); grid = -1; return; }
        int dev = 0, cus = 0, per_cu = 0;
        if (hipGetDevice(&dev) != hipSuccess || hipDeviceGetAttribute(&cus, hipDeviceAttributeMultiprocessorCount, dev) != hipSuccess) { grid = -1; return; }
        if (hipFuncSetAttribute((const void*)fwd_kernel, hipFuncAttributeMaxDynamicSharedMemorySize, LDS_BYTES) != hipSuccess) { fprintf(stderr, "kernel_launch: hipFuncSetAttribute failed\n"); grid = -1; return; }
        if (hipOccupancyMaxActiveBlocksPerMultiprocessor(&per_cu, (const void*)fwd_kernel, NWAVES * 64, LDS_BYTES) != hipSuccess || per_cu < 1) { fprintf(stderr, "kernel_launch: occupancy query reports %d blocks per CU\n", per_cu); per_cu = 1; }
        (void)hipGetLastError();
        grid = cus;
    }
    if (grid < 0) return;
    (void)hipMemsetAsync((char*)d_ws + WS_CTL, 0, CTL_ZERO_BYTES, stream);
    Args a{};
    for (int i = 0; i < 19; ++i) a.in.p[i] = (const float*)d_in[i];
    a.out = (float*)d_out; a.ws = (unsigned char*)d_ws;
    a.reps[0] = REP_CMP; a.reps[1] = REP_NSA; a.reps[2] = REP_SB; a.reps[3] = 1;
    if (MK_N_LAUNCHES == 1) {
        a.ph_lo = 0; a.ph_hi = N_PHASES;
        hipLaunchKernelGGL(fwd_kernel, dim3(grid), dim3(NWAVES * 64), LDS_BYTES, stream, a);
    } else {
        for (int li = 0; li < 9; ++li) { a.ph_lo = li; a.ph_hi = li + 1;
            hipLaunchKernelGGL(fwd_kernel, dim3(grid), dim3(NWAVES * 64), LDS_BYTES, stream, a); }
    }
}
```
